# Optimizing an MI355X kernel written in HIP

```python
import math
import jax
import jax.numpy as jnp
from jax import lax
import numpy as np

D_MODEL = 1024
BATCH = 8
SEQ = 4096
DEPTH = 2

HEAD_DIM = 64
N_HEADS = D_MODEL // HEAD_DIM
MIX_WIDTH = N_HEADS * HEAD_DIM
A_HEADS = N_HEADS // 2
B_HEADS = N_HEADS // 4
B_KV_HEADS = B_HEADS // 2
C_HEADS = N_HEADS // 4
C_KV_HEADS = C_HEADS // 2
DILATED_PATTERNS = ((128, 1), (512, 4), (2048, 16))
C_RADIUS = 128
Q_BLOCK = 128
GRID_W = 64
ROPE_THETA = 10000.0
D_FF = 2816
EPS = 1e-6
MASK_VALUE = -1e30
PROJ_SIZES = (A_HEADS * HEAD_DIM, A_HEADS * HEAD_DIM, A_HEADS * HEAD_DIM,
              B_HEADS * HEAD_DIM, B_KV_HEADS * HEAD_DIM, B_KV_HEADS * HEAD_DIM,
              C_HEADS * HEAD_DIM, C_KV_HEADS * HEAD_DIM, C_KV_HEADS * HEAD_DIM)
PROJ_WIDTH = sum(PROJ_SIZES)

kernel_name = 'hybrid_dilated_axial_window_encoder'


def rms_norm(x, g):
    xf = x.astype(jnp.float32)
    y = xf * lax.rsqrt(jnp.mean(xf * xf, axis=-1, keepdims=True) + EPS)
    return (y * g.astype(jnp.float32)).astype(x.dtype)


def rope_tables(pos, dim):
    inv_freq = 1.0 / (ROPE_THETA ** (jnp.arange(0, dim, 2, dtype=jnp.float32) / dim))
    ang = pos.astype(jnp.float32)[:, None] * inv_freq[None, :]
    ang = jnp.concatenate([ang, ang], axis=-1)
    return jnp.cos(ang), jnp.sin(ang)


def apply_rope(x, cos, sin):
    xf = x.astype(jnp.float32)
    half = xf.shape[-1] // 2
    rot = jnp.concatenate([-xf[..., half:], xf[..., :half]], axis=-1)
    return (xf * cos[:, None, :] + rot * sin[:, None, :]).astype(x.dtype)


def apply_axial_rope(x, cos_r, sin_r, cos_c, sin_c):
    half = x.shape[-1] // 2
    return jnp.concatenate([apply_rope(x[..., :half], cos_r, sin_r),
                            apply_rope(x[..., half:], cos_c, sin_c)], axis=-1)


def to_residue(x, d):
    b, s = x.shape[:2]
    rest = x.shape[2:]
    x = x.reshape((b, s // d, d) + rest)
    return jnp.moveaxis(x, 2, 1).reshape((b * d, s // d) + rest)


def from_residue(x, batch, d):
    n_slots = x.shape[1]
    rest = x.shape[2:]
    x = x.reshape((batch, d, n_slots) + rest)
    return jnp.moveaxis(x, 1, 2).reshape((batch, d * n_slots) + rest)


def banded_attention(q, k, v, radius, sink=None):
    n, seq_len, hq, dh = q.shape
    hkv = k.shape[2]
    rep = hq // hkv
    qb = math.gcd(radius, seq_len)
    nb = seq_len // qb
    kw = qb + 2 * radius
    pad = ((0, 0), (radius, radius), (0, 0), (0, 0))
    kp = jnp.pad(k, pad)
    vp = jnp.pad(v, pad)
    idx = (jnp.arange(nb) * qb)[:, None] + jnp.arange(kw)[None, :]
    kb = kp[:, idx]
    vb = vp[:, idx]
    qr = q.reshape(n, nb, qb, hkv, rep, dh)
    s = jnp.einsum('nbqgrd,nbkgd->nbgrqk', qr, kb,
                   preferred_element_type=jnp.float32) / math.sqrt(dh)
    kpos = idx - radius
    rel = jnp.arange(kw)[None, :] - radius - jnp.arange(qb)[:, None]
    valid = (jnp.abs(rel) <= radius)[None] & ((kpos >= 0) & (kpos < seq_len))[:, None, :]
    s = jnp.where(valid[None, :, None, None], s, MASK_VALUE)
    m = jnp.max(s, axis=-1)
    if sink is not None:
        sink_b = sink.astype(jnp.float32).reshape(hkv, rep)[None, None, :, :, None]
        m = jnp.maximum(m, sink_b)
    p = jnp.exp(s - m[..., None])
    denom = jnp.sum(p, axis=-1)
    if sink is not None:
        denom = denom + jnp.exp(sink_b - m)
    o = jnp.einsum('nbgrqk,nbkgd->nbqgrd', p.astype(v.dtype), vb,
                   preferred_element_type=jnp.float32)
    o = o / jnp.moveaxis(denom, -1, 2)[..., None]
    lse = jnp.moveaxis(m + jnp.log(denom), -1, 2).reshape(n, seq_len, hq)
    return o.reshape(n, seq_len, hq, dh).astype(v.dtype), lse


def dense_gqa_blocked(q, k, v):
    b, s, hq, dh = q.shape
    hkv = k.shape[2]
    rep = hq // hkv
    nb = s // Q_BLOCK
    qs = jnp.moveaxis(q.reshape(b, nb, Q_BLOCK, hkv, rep, dh), 1, 0)
    scale = 1.0 / math.sqrt(dh)

    def one_block(qblk):
        sc = jnp.einsum('bqgrd,bkgd->bgrqk', qblk, k,
                        preferred_element_type=jnp.float32) * scale
        p = jax.nn.softmax(sc, axis=-1)
        return jnp.einsum('bgrqk,bkgd->bqgrd', p.astype(v.dtype), v)

    o = lax.map(one_block, qs)
    return jnp.moveaxis(o, 0, 1).reshape(b, s, hq, dh)


def half_swiglu(x, g, w_gate, w_up, w_down):
    h = rms_norm(x, g)
    u = jax.nn.silu(h @ w_gate) * (h @ w_up)
    return x + 0.5 * (u @ w_down)


def hybrid_mixer(x, g_mix, w_in, a_qn, a_kn, b_qn, b_kn, c_qn, c_kn, c_sink, g_group, w_out,
                 cos1, sin1, cos_r, sin_r, cos_c, sin_c):
    b, s, _ = x.shape
    h = rms_norm(x, g_mix)
    proj = h @ w_in
    offsets = []
    acc = 0
    for size in PROJ_SIZES[:-1]:
        acc += size
        offsets.append(acc)
    aq, ak, av, bq, bk, bv, cq, ck, cv = jnp.split(proj, offsets, axis=-1)

    def heads(t, n_h):
        return t.reshape(b, s, n_h, HEAD_DIM)

    aq = apply_rope(rms_norm(heads(aq, A_HEADS), a_qn), cos1, sin1)
    ak = apply_rope(rms_norm(heads(ak, A_HEADS), a_kn), cos1, sin1)
    av = heads(av, A_HEADS)
    outs, lses = [], []
    for window, dil in DILATED_PATTERNS:
        o, lse = banded_attention(to_residue(aq, dil), to_residue(ak, dil), to_residue(av, dil),
                                  window // (2 * dil))
        outs.append(from_residue(o, b, dil))
        lses.append(from_residue(lse, b, dil))
    mix_w = jax.nn.softmax(jnp.stack(lses, axis=0), axis=0)
    oa = jnp.sum(mix_w[..., None] * jnp.stack(outs, axis=0).astype(jnp.float32),
                 axis=0).astype(x.dtype)

    bq = apply_axial_rope(rms_norm(heads(bq, B_HEADS), b_qn), cos_r, sin_r, cos_c, sin_c)
    bk = apply_axial_rope(rms_norm(heads(bk, B_KV_HEADS), b_kn), cos_r, sin_r, cos_c, sin_c)
    ob = dense_gqa_blocked(bq, bk, heads(bv, B_KV_HEADS))

    cq = apply_rope(rms_norm(heads(cq, C_HEADS), c_qn), cos1, sin1)
    ck = apply_rope(rms_norm(heads(ck, C_KV_HEADS), c_kn), cos1, sin1)
    oc, _ = banded_attention(cq, ck, heads(cv, C_KV_HEADS), C_RADIUS, c_sink)

    wa = A_HEADS * HEAD_DIM
    wb = B_HEADS * HEAD_DIM
    oa = rms_norm(oa.reshape(b, s, wa), g_group[:wa])
    ob = rms_norm(ob.reshape(b, s, wb), g_group[wa:wa + wb])
    oc = rms_norm(oc.reshape(b, s, -1), g_group[wa + wb:])
    return jnp.concatenate([oa, ob, oc], axis=-1) @ w_out


def setup_inputs(seed: int = 0) -> dict:
    key = jax.random.key(seed)
    ks = jax.random.split(key, 20)

    def w(k, shape, fan_in):
        return jax.random.normal(k, shape, jnp.float32) * fan_in ** -0.5

    def gain(k, shape):
        return 1.0 + 0.02 * jax.random.normal(k, shape, jnp.float32)

    return {
        'x': jax.random.normal(ks[0], (BATCH, SEQ, D_MODEL), jnp.float32),
        'ffn1_norm': gain(ks[1], (DEPTH, D_MODEL)),
        'ffn1_w_gate': w(ks[2], (DEPTH, D_MODEL, D_FF), D_MODEL),
        'ffn1_w_up': w(ks[3], (DEPTH, D_MODEL, D_FF), D_MODEL),
        'ffn1_w_down': w(ks[4], (DEPTH, D_FF, D_MODEL), D_FF),
        'mix_norm': gain(ks[5], (DEPTH, D_MODEL)),
        'w_in': w(ks[6], (DEPTH, D_MODEL, PROJ_WIDTH), D_MODEL),
        'a_q_norm': gain(ks[7], (DEPTH, HEAD_DIM)),
        'a_k_norm': gain(ks[8], (DEPTH, HEAD_DIM)),
        'b_q_norm': gain(ks[9], (DEPTH, HEAD_DIM)),
        'b_k_norm': gain(ks[10], (DEPTH, HEAD_DIM)),
        'c_q_norm': gain(ks[11], (DEPTH, HEAD_DIM)),
        'c_k_norm': gain(ks[12], (DEPTH, HEAD_DIM)),
        'c_sink': 0.5 * jax.random.normal(ks[13], (DEPTH, C_HEADS), jnp.float32),
        'group_norm': gain(ks[14], (DEPTH, MIX_WIDTH)),
        'w_out': w(ks[15], (DEPTH, MIX_WIDTH, D_MODEL), MIX_WIDTH),
        'ffn2_norm': gain(ks[16], (DEPTH, D_MODEL)),
        'ffn2_w_gate': w(ks[17], (DEPTH, D_MODEL, D_FF), D_MODEL),
        'ffn2_w_up': w(ks[18], (DEPTH, D_MODEL, D_FF), D_MODEL),
        'ffn2_w_down': w(ks[19], (DEPTH, D_FF, D_MODEL), D_FF),
    }


def reference(x, ffn1_norm, ffn1_w_gate, ffn1_w_up, ffn1_w_down, mix_norm, w_in,
              a_q_norm, a_k_norm, b_q_norm, b_k_norm, c_q_norm, c_k_norm, c_sink,
              group_norm, w_out, ffn2_norm, ffn2_w_gate, ffn2_w_up, ffn2_w_down):
    s = x.shape[1]
    rows = s // GRID_W
    t = jnp.arange(s)
    row = jnp.repeat(jnp.arange(rows), GRID_W)
    col = jnp.tile(jnp.arange(GRID_W), rows)
    cos1, sin1 = rope_tables(t, HEAD_DIM)
    cos_r, sin_r = rope_tables(row, HEAD_DIM // 2)
    cos_c, sin_c = rope_tables(col, HEAD_DIM // 2)
    for l in range(DEPTH):
        x = half_swiglu(x, ffn1_norm[l], ffn1_w_gate[l], ffn1_w_up[l], ffn1_w_down[l])
        x = x + hybrid_mixer(x, mix_norm[l], w_in[l], a_q_norm[l], a_k_norm[l],
                             b_q_norm[l], b_k_norm[l], c_q_norm[l], c_k_norm[l], c_sink[l],
                             group_norm[l], w_out[l],
                             cos1, sin1, cos_r, sin_r, cos_c, sin_c)
        x = half_swiglu(x, ffn2_norm[l], ffn2_w_gate[l], ffn2_w_up[l], ffn2_w_down[l])
    return x
```

```cpp
#include <hip/hip_runtime.h>
#include <hip/hip_cooperative_groups.h>
#include <cstdio>
#include <cstdint>
namespace cg = cooperative_groups;
__device__ __forceinline__ int lane_id_fresh() { unsigned z; asm volatile("s_mov_b32 %0, 0" : "=s"(z)); return (int)__builtin_amdgcn_mbcnt_hi(~0u, __builtin_amdgcn_mbcnt_lo(~0u, z)); }
__device__ __forceinline__ int fresh_wave(int w) { asm volatile("" : "+s"(w)); return w; }
namespace pg8 {
#define PG8_LAS __attribute__((address_space(3)))
typedef unsigned short bf16_t;
typedef short bf16x8 __attribute__((ext_vector_type(8)));
typedef float f32x4 __attribute__((ext_vector_type(4)));
typedef unsigned u32x4 __attribute__((ext_vector_type(4)));
constexpr int BM = 256, BK = 64, HALF = 128, HTB = HALF * BK * 2  , STAGE_BYTES = 8 * HTB, NXCD = 8, WGM = 8;

__host__ __device__ __forceinline__ int lds_byte(int r, int c) { const int st = (r >> 4) * 2 + (c >> 5), rr = r & 15, cc = c & 31, ob = rr * 64 + cc * 2; return st * 1024 + (ob ^ (((ob >> 9) & 1) << 5)); }
__host__ __device__ __forceinline__ void stage_rc(int b, int& R, int& C) { const int st = b / 1024, sb = b % 1024, swz = sb ^ (((sb >> 9) & 1) << 5); R = (st >> 1) * 16 + swz / 64; C = (st & 1) * 32 + (swz % 64) / 2; }
__host__ __device__ __forceinline__ int perm32(int rho) { const int n = rho >> 4, i = rho & 15; return 8 * (i >> 2) + 4 * n + (i & 3); }

struct Unit { int pm, pn; };
struct Gemm { const bf16_t* A; const bf16_t* Bt; int M, N, K; };

struct StaticOrder {
    int nM, nN, nwg, G, c;
    __host__ __device__ void init(int M, int N, int G_, int c_) { nM = M / BM; nN = N / BM; nwg = nM * nN; G = G_; c = c_; }
    __host__ __device__ bool next(int i, Unit& u) const {
        const long L = (long)i * G + c; if (L >= nwg) return false;
        int wgid = (int)L; { const int q = nwg / NXCD, r = nwg % NXCD, xcd = wgid % NXCD, off = wgid / NXCD; wgid = (xcd < r ? xcd * (q + 1) : r * (q + 1) + (xcd - r) * q) + off; }
        const int nig = WGM * nN, gid = wgid / nig, fm = gid * WGM, gsz = (nM - fm) < WGM ? (nM - fm) : WGM;
        u.pm = fm + ((wgid % nig) % gsz); u.pn = (wgid % nig) / gsz; return true;
    }
    __device__ __forceinline__ void a_ready(const Unit&) const {}
    __device__ __forceinline__ void done(const Unit&) const {}
};

__device__ __forceinline__ unsigned cvt_pk_bf16(float lo, float hi) { unsigned r; asm volatile("v_cvt_pk_bf16_f32 %0, %1, %2" : "=v"(r) : "v"(lo), "v"(hi)); return r; }
typedef float f32x2 __attribute__((ext_vector_type(2)));
__device__ __forceinline__ f32x2 gelu_pk(f32x2 v) {
    const f32x2 av = __builtin_elementwise_abs(v), d = av * 0.2316418882f + 1.0f;
    f32x2 t; t.x = __builtin_amdgcn_rcpf(d.x); t.y = __builtin_amdgcn_rcpf(d.y);
    f32x2 q = t * 0.5307027145f + (-0.7265760135f); q = q * t + 0.7107068705f; q = q * t + (-0.142248368f); q = q * t + 0.127414796f; q = q * t;
    const f32x2 s = (v * v) * (-0.72134752044f);
    f32x2 e; e.x = __builtin_amdgcn_exp2f(s.x); e.y = __builtin_amdgcn_exp2f(s.y);
    const f32x2 m = v * (q * e), r = v - m;
    f32x2 o; o.x = v.x < 0.f ? m.x : r.x; o.y = v.y < 0.f ? m.y : r.y; return o;
}

template <int ACT  > struct EpiBf16 {
    static constexpr bool PERM = true, AFTER_DRAIN = false; static_assert(ACT == 0 || ACT == 1, "EpiBf16: ACT is 0 (none) or 1 (gelu_pk)");
    bf16_t* O; int ldc; const float* bias; int split_cols; size_t split_stride; float scale0;
    __device__ __forceinline__ void operator()(const f32x4 (&acc)[2][2][4][2], const Unit& u, int wr, int wc, int fr, int fq) const {
        const int row0 = u.pm * BM + wr * 64 + fr; int colt = u.pn * BM; bf16_t* base = O;
        float sc = 1.f; if (split_cols) { const int t = colt / split_cols; base += (size_t)t * split_stride; colt -= t * split_cols; if (t == 0) sc = scale0; }
        const int col0 = colt + wc * 32 + 8 * fq, bcol0 = u.pn * BM + wc * 32 + 8 * fq;
        f32x4 bv[2][2];
#pragma unroll
        for (int bj = 0; bj < 2; ++bj)
#pragma unroll
            for (int n = 0; n < 2; ++n) bv[bj][n] = bias ? *(const f32x4*)(bias + bcol0 + bj * HALF + 4 * n) : (f32x4){0.f, 0.f, 0.f, 0.f};
#pragma unroll
        for (int ai = 0; ai < 2; ++ai)
#pragma unroll
            for (int m = 0; m < 4; ++m) { bf16_t* rowp = base + (size_t)(row0 + ai * HALF + m * 16) * ldc + col0;
#pragma unroll
                for (int bj = 0; bj < 2; ++bj) { f32x4 v0 = acc[ai][bj][m][0] + bv[bj][0], v1 = acc[ai][bj][m][1] + bv[bj][1];
                    if (ACT == 1) { f32x2 a = gelu_pk((f32x2){v0[0], v0[1]}), b = gelu_pk((f32x2){v0[2], v0[3]}), c = gelu_pk((f32x2){v1[0], v1[1]}), d = gelu_pk((f32x2){v1[2], v1[3]});
                        v0 = (f32x4){a.x, a.y, b.x, b.y}; v1 = (f32x4){c.x, c.y, d.x, d.y}; }
                    v0 = v0 * sc; v1 = v1 * sc; u32x4 w; w.x = cvt_pk_bf16(v0[0], v0[1]); w.y = cvt_pk_bf16(v0[2], v0[3]); w.z = cvt_pk_bf16(v1[0], v1[1]); w.w = cvt_pk_bf16(v1[2], v1[3]);
                    *(u32x4*)(rowp + bj * HALF) = w; } }
    }
};
typedef unsigned u32x2 __attribute__((ext_vector_type(2)));
struct EpiSwiglu {
    static constexpr bool PERM = true, AFTER_DRAIN = false;
    bf16_t* O; int ldc; const float* ss;
    __device__ __forceinline__ void operator()(const f32x4 (&acc)[2][2][4][2], const Unit& u, int wr, int wc, int fr, int fq) const {
        const int row0 = u.pm * BM + wr * 64 + fr; const int col0 = u.pn * HALF + wc * 32 + 8 * fq;
#pragma unroll
        for (int ai = 0; ai < 2; ++ai)
#pragma unroll
            for (int m = 0; m < 4; ++m) {
                const int row = row0 + ai * HALF + m * 16;
                const float rs = ss[row];
                bf16_t* rowp = O + (size_t)row * ldc + col0;
                float v[8];
#pragma unroll
                for (int n = 0; n < 2; ++n)
#pragma unroll
                    for (int i = 0; i < 4; ++i) { const float ag = acc[ai][0][m][n][i], au = acc[ai][1][m][n][i];
                        const float e = __builtin_amdgcn_exp2f(ag * rs);
                        v[n * 4 + i] = (ag * au) * __builtin_amdgcn_rcpf(1.0f + e); }
                u32x4 w; w.x = cvt_pk_bf16(v[0], v[1]); w.y = cvt_pk_bf16(v[2], v[3]); w.z = cvt_pk_bf16(v[4], v[5]); w.w = cvt_pk_bf16(v[6], v[7]);
                *(u32x4*)rowp = w;
            }
    }
};
struct EpiResid {
    static constexpr bool PERM = true, AFTER_DRAIN = false;
    bf16_t* xb; float* fout; int ldc; float scale; float* ssout; const float* rowrs; float rowk;
    __device__ __forceinline__ void operator()(const f32x4 (&acc)[2][2][4][2], const Unit& u, int wr, int wc, int fr, int fq) const {
        const int row0 = u.pm * BM + wr * 64 + fr; const int col0 = u.pn * BM + wc * 32 + 8 * fq;
#pragma unroll
        for (int ai = 0; ai < 2; ++ai) {
            u32x4 b[4][2];
#pragma unroll
            for (int m = 0; m < 4; ++m) { const size_t off = (size_t)(row0 + ai * HALF + m * 16) * ldc + col0;
#pragma unroll
                for (int bj = 0; bj < 2; ++bj) b[m][bj] = *(const u32x4*)(xb + off + bj * HALF); }
            asm volatile("" ::: "memory");
#pragma unroll
            for (int m = 0; m < 4; ++m) { const int row = row0 + ai * HALF + m * 16; const size_t off = (size_t)row * ldc + col0; float s = 0.f;
                float sc = scale; if (rowrs) { const float r_ = rowrs[row]; sc = scale * rowk * r_ * r_; }
#pragma unroll
                for (int bj = 0; bj < 2; ++bj) { const u32x4 w = b[m][bj];
                    f32x4 r0 = {__builtin_bit_cast(float, w.x << 16), __builtin_bit_cast(float, w.x & 0xffff0000u), __builtin_bit_cast(float, w.y << 16), __builtin_bit_cast(float, w.y & 0xffff0000u)};
                    f32x4 r1 = {__builtin_bit_cast(float, w.z << 16), __builtin_bit_cast(float, w.z & 0xffff0000u), __builtin_bit_cast(float, w.w << 16), __builtin_bit_cast(float, w.w & 0xffff0000u)};
                    r0 = r0 + acc[ai][bj][m][0] * sc; r1 = r1 + acc[ai][bj][m][1] * sc;
                    if (fout) { *(f32x4*)(fout + off + bj * HALF) = r0; *(f32x4*)(fout + off + bj * HALF + 4) = r1; }
                    else { s += (r0[0] * r0[0] + r0[1] * r0[1]) + (r0[2] * r0[2] + r0[3] * r0[3]) + (r1[0] * r1[0] + r1[1] * r1[1]) + (r1[2] * r1[2] + r1[3] * r1[3]);
                        u32x4 o; o.x = cvt_pk_bf16(r0[0], r0[1]); o.y = cvt_pk_bf16(r0[2], r0[3]); o.z = cvt_pk_bf16(r1[0], r1[1]); o.w = cvt_pk_bf16(r1[2], r1[3]);
                        *(u32x4*)(xb + off + bj * HALF) = o; } }
                if (!fout) { s += __shfl_xor(s, 16); s += __shfl_xor(s, 32); if (fq == 0) ssout[(size_t)row * 16 + u.pn * 4 + wc] = s; } }
            asm volatile("" ::: "memory");
        }
    }
};
struct EpiQKV {
    static constexpr bool PERM = true, AFTER_DRAIN = false;
    bf16_t* O; const float* ss; const float *aqn, *akn, *bqn, *bkn, *cqn, *ckn; const float *cos1, *sin1, *cosx, *sinx; float qscale;
    __device__ __forceinline__ void operator()(const f32x4 (&acc)[2][2][4][2], const Unit& u, int wr, int wc, int fr, int fq) const {
        const int hidx = 4 * u.pn + wc;
        int kind = 0; const float* gp = aqn; bool isq = false;
        if (hidx < 8) { kind = 1; gp = aqn; isq = true; } else if (hidx < 16) { kind = 1; gp = akn; }
        else if (hidx < 24) { kind = 0; } else if (hidx < 28) { kind = 2; gp = bqn; isq = true; } else if (hidx < 30) { kind = 2; gp = bkn; }
        else if (hidx < 32) { kind = 0; } else if (hidx < 36) { kind = 1; gp = cqn; isq = true; } else if (hidx < 38) { kind = 1; gp = ckn; }
        const int row0 = u.pm * BM + wr * 64 + fr;
        bf16_t* obase = O + hidx * 64 + 8 * fq;
        if (kind == 0) {
            float rsv[8];
#pragma unroll
            for (int g = 0; g < 8; ++g) rsv[g] = ss[row0 + (g >> 2) * HALF + (g & 3) * 16];
#pragma unroll
            for (int g = 0; g < 8; ++g) { const int ai = g >> 2, m = g & 3; const int row = row0 + ai * HALF + m * 16; const float rs = rsv[g];
#pragma unroll
                for (int bj = 0; bj < 2; ++bj) { const f32x4 x0 = acc[ai][bj][m][0] * rs, x1 = acc[ai][bj][m][1] * rs;
                    u32x4 w; w.x = cvt_pk_bf16(x0[0], x0[1]); w.y = cvt_pk_bf16(x0[2], x0[3]); w.z = cvt_pk_bf16(x1[0], x1[1]); w.w = cvt_pk_bf16(x1[2], x1[3]);
                    *(u32x4*)(obase + (size_t)row * 2560 + 32 * bj) = w; } }
            return;
        }
        const float* gpl = gp + (kind == 2 ? 4 * fq : 8 * fq); const int gstep = (kind == 2 ? 16 : 4);
        const float hs = isq ? qscale : 1.0f;
        f32x4 tc[2][2], ts[2][2]; float rsb[2];
        auto load_tabs = [&](int g, f32x4 (&c)[2], f32x4 (&sn)[2]) {
            const int t = (row0 + (g >> 2) * HALF + (g & 3) * 16) & 4095; rsb[g & 1] = ss[row0 + (g >> 2) * HALF + (g & 3) * 16];
            if (kind == 1) {
#pragma unroll
                for (int n = 0; n < 2; ++n) { c[n] = *(const f32x4*)(cos1 + t * 32 + 8 * fq + 4 * n); sn[n] = *(const f32x4*)(sin1 + t * 32 + 8 * fq + 4 * n); }
            } else {
#pragma unroll
                for (int bj = 0; bj < 2; ++bj) { const int pos = bj == 0 ? (t >> 6) : (t & 63); c[bj] = *(const f32x4*)(cosx + pos * 16 + 4 * fq); sn[bj] = *(const f32x4*)(sinx + pos * 16 + 4 * fq); }
            }
        };
        float ssq[8];
#pragma unroll
        for (int g = 0; g < 8; ++g) { const int ai = g >> 2, m = g & 3; float q = 0.f;
#pragma unroll
            for (int bj = 0; bj < 2; ++bj)
#pragma unroll
                for (int n = 0; n < 2; ++n) { const f32x4 a = acc[ai][bj][m][n]; q += (a[0] * a[0] + a[1] * a[1]) + (a[2] * a[2] + a[3] * a[3]); }
            ssq[g] = q; }
        load_tabs(0, tc[0], ts[0]);
#pragma unroll
        for (int g = 0; g < 8; ++g) ssq[g] += __shfl_xor(ssq[g], 16);
#pragma unroll
        for (int g = 0; g < 8; ++g) ssq[g] += __shfl_xor(ssq[g], 32);
#pragma unroll
        for (int g = 0; g < 8; ++g) {
            const int ai = g >> 2, m = g & 3, cur = g & 1;
            if (g + 1 < 8) load_tabs(g + 1, tc[cur ^ 1], ts[cur ^ 1]);
            asm volatile("" ::: "memory");
            const int row = row0 + ai * HALF + m * 16; const float rs = rsb[g & 1];
            const float sc = rs * hs / sqrtf(rs * rs * ssq[g] * (1.0f / 64.0f) + 1e-6f);
            f32x4 x[2][2];
#pragma unroll
            for (int bj = 0; bj < 2; ++bj)
#pragma unroll
                for (int n = 0; n < 2; ++n) x[bj][n] = acc[ai][bj][m][n] * sc * *(const f32x4*)(gpl + 32 * bj + gstep * n);
            if (kind == 1) {
#pragma unroll
                for (int n = 0; n < 2; ++n) { const f32x4 c = tc[cur][n], sn = ts[cur][n];
                    const f32x4 o0 = x[0][n] * c - x[1][n] * sn, o1 = x[1][n] * c + x[0][n] * sn; x[0][n] = o0; x[1][n] = o1; }
            } else {
#pragma unroll
                for (int bj = 0; bj < 2; ++bj) { const f32x4 c = tc[cur][bj], sn = ts[cur][bj];
                    const f32x4 o0 = x[bj][0] * c - x[bj][1] * sn, o1 = x[bj][1] * c + x[bj][0] * sn; x[bj][0] = o0; x[bj][1] = o1; }
            }
#pragma unroll
            for (int bj = 0; bj < 2; ++bj) { u32x4 w; w.x = cvt_pk_bf16(x[bj][0][0], x[bj][0][1]); w.y = cvt_pk_bf16(x[bj][0][2], x[bj][0][3]);
                w.z = cvt_pk_bf16(x[bj][1][0], x[bj][1][1]); w.w = cvt_pk_bf16(x[bj][1][2], x[bj][1][3]);
                *(u32x4*)(obase + (size_t)row * 2560 + 32 * bj) = w; }
        }
    }
};
template <class Epi, class Sched, bool ALIGN_EPI = false, bool SP2 = false>
__device__ __forceinline__ void gemm_phase(PG8_LAS unsigned char* lds, const Gemm g, const Sched& S, const Epi& E, const int wave0_) {
    const int wave0 = fresh_wave(wave0_);
    const int tid = wave0 * 64 + lane_id_fresh(), wid = wave0, lane = tid & 63, wr = wid >> 2, wc = wid & 3, fr = lane & 15, fq = lane >> 4;
    const int K = g.K, nt = K / BK;
    unsigned voffA[2], voffB[2];
#pragma unroll
    for (int i = 0; i < 2; ++i) { int R, C; stage_rc(tid * 16 + i * 8192, R, C); const int Rb = Epi::PERM ? ((R & ~31) + perm32(R & 31)) : R;
        voffA[i] = (unsigned)(R * K + C) * 2u; voffB[i] = (unsigned)(Rb * K + C) * 2u; }
    const size_t kstep = (size_t)(BK * 2);
    const size_t hstep = (size_t)HALF * K * 2;
    const size_t tstep = 2 * hstep;
    const unsigned ldsw = (unsigned)wid * 1024u;
    const int aoff = lds_byte(wr * 64 + fr, fq * 8), boff = lds_byte(wc * 32 + fr, fq * 8);
#define PG8_SA(b, h) (((b) * 2 + (h)) * HTB)
#define PG8_SB(b, h) ((4 + (b) * 2 + (h)) * HTB)
#define PG8_STAGE(bufoff, gbase, voff) do { _Pragma("unroll") for (int _i = 0; _i < 2; ++_i) \
        __builtin_amdgcn_global_load_lds((const unsigned*)((const char*)(gbase) + (voff)[_i]), (PG8_LAS unsigned*)(lds + (bufoff) + ldsw + _i * 8192), 16, 0, 0); } while (0)
#define PG8_LDA(dst, b, h) do { _Pragma("unroll") for (int m = 0; m < 4; ++m) _Pragma("unroll") for (int k = 0; k < 2; ++k) dst[m][k] = *(const PG8_LAS bf16x8*)(lds + PG8_SA(b, h) + aoff + m * 2048 + k * 1024); } while (0)
#define PG8_LDB(dst, b, h) do { _Pragma("unroll") for (int n = 0; n < 2; ++n) _Pragma("unroll") for (int k = 0; k < 2; ++k) dst[n][k] = *(const PG8_LAS bf16x8*)(lds + PG8_SB(b, h) + boff + n * 2048 + k * 1024); } while (0)
#define PG8_MMA(ai, bj, At, Bt) do { __builtin_amdgcn_s_setprio(1); _Pragma("unroll") for (int m = 0; m < 4; ++m) _Pragma("unroll") for (int n = 0; n < 2; ++n) _Pragma("unroll") for (int k = 0; k < 2; ++k) \
        acc[ai][bj][m][n] = __builtin_amdgcn_mfma_f32_16x16x32_bf16(Bt[n][k], At[m][k], acc[ai][bj][m][n], 0, 0, 0); __builtin_amdgcn_s_setprio(0); } while (0)
#define PG8_WAIT_V(n) asm volatile("s_waitcnt vmcnt(" #n ")" ::: "memory")
#define PG8_WAIT_L(n) asm volatile("s_waitcnt lgkmcnt(" #n ")" ::: "memory")
#define PG8_BAR __builtin_amdgcn_s_barrier()
#define PG8_SCHED __builtin_amdgcn_sched_barrier(0)
    Unit cur, nxt; int ui = 0;
    if (!S.next(0, cur)) return;
    f32x4 acc[2][2][4][2];
#pragma unroll
    for (int a = 0; a < 2; ++a)
#pragma unroll
        for (int b = 0; b < 2; ++b)
#pragma unroll
            for (int m = 0; m < 4; ++m)
#pragma unroll
                for (int n = 0; n < 2; ++n) acc[a][b][m][n] = (f32x4){0.f, 0.f, 0.f, 0.f};
    bf16x8 At[4][2], B0[2][2], B1[2][2];
    const char* cA = (const char*)g.A + (size_t)cur.pm * tstep; const char* cB = (const char*)g.Bt + (size_t)cur.pn * tstep;
    S.a_ready(cur);
    if constexpr (SP2) {
        PG8_STAGE(PG8_SB(0, 0), cB, voffB); PG8_STAGE(PG8_SB(0, 1), cB + hstep, voffB); PG8_STAGE(PG8_SA(0, 0), cA, voffA); PG8_STAGE(PG8_SA(0, 1), cA + hstep, voffA);
        if (wr == 1) PG8_BAR;
        PG8_WAIT_V(2); PG8_BAR;
        PG8_STAGE(PG8_SB(1, 0), cB + kstep, voffB); PG8_STAGE(PG8_SA(1, 0), cA + kstep, voffA); PG8_STAGE(PG8_SB(1, 1), cB + hstep + kstep, voffB);
        PG8_WAIT_V(6); PG8_BAR;
    } else {
        PG8_STAGE(PG8_SB(0, 0), cB, voffB); PG8_STAGE(PG8_SA(0, 0), cA, voffA); PG8_STAGE(PG8_SB(0, 1), cB + hstep, voffB); PG8_STAGE(PG8_SA(0, 1), cA + hstep, voffA);
        if (wr == 1) PG8_BAR;
        PG8_WAIT_V(4); PG8_BAR;
        PG8_STAGE(PG8_SB(1, 0), cB + kstep, voffB); PG8_STAGE(PG8_SA(1, 0), cA + kstep, voffA); PG8_STAGE(PG8_SB(1, 1), cB + hstep + kstep, voffB);
        PG8_WAIT_V(6); PG8_BAR;
    }
    for (;;) {
        const bool has_next = S.next(ui + 1, nxt);
        const char* nA = has_next ? (const char*)g.A + (size_t)nxt.pm * tstep : cA; const char* nB = has_next ? (const char*)g.Bt + (size_t)nxt.pn * tstep : cB;
        for (int t = 0; t < nt; t += 2) {
            const bool last = (t == nt - 2);
            const char* a1 = cA + (size_t)(t + 1) * kstep;
            const char* a2 = last ? nA : cA + (size_t)(t + 2) * kstep; const char* b2 = last ? nB : cB + (size_t)(t + 2) * kstep;
            const char* a3 = a2 + kstep; const char* b3 = b2 + kstep;
            if (last && has_next) S.a_ready(nxt);
            if constexpr (SP2) {
            PG8_LDB(B0, 0, 0); PG8_LDB(B1, 0, 1); PG8_SCHED; PG8_LDA(At, 0, 0); PG8_STAGE(PG8_SA(1, 1), a1 + hstep, voffA);
            PG8_WAIT_V(8); PG8_WAIT_L(0); PG8_BAR; PG8_MMA(0, 0, At, B0); PG8_MMA(0, 1, At, B1); PG8_BAR; PG8_SCHED;
            PG8_LDA(At, 0, 1); PG8_STAGE(PG8_SB(0, 0), b2, voffB); PG8_STAGE(PG8_SB(0, 1), b2 + hstep, voffB); PG8_STAGE(PG8_SA(0, 0), a2, voffA);
            PG8_WAIT_V(8); PG8_WAIT_L(0); PG8_BAR; PG8_MMA(1, 0, At, B0); PG8_MMA(1, 1, At, B1); PG8_BAR; PG8_SCHED;
            PG8_LDB(B0, 1, 0); PG8_LDB(B1, 1, 1); PG8_SCHED; PG8_LDA(At, 1, 0); PG8_STAGE(PG8_SA(0, 1), a2 + hstep, voffA);
            PG8_WAIT_V(8); PG8_WAIT_L(0); PG8_BAR; PG8_MMA(0, 0, At, B0); PG8_MMA(0, 1, At, B1); PG8_BAR; PG8_SCHED;
            PG8_LDA(At, 1, 1); PG8_STAGE(PG8_SB(1, 0), b3, voffB); PG8_STAGE(PG8_SB(1, 1), b3 + hstep, voffB); PG8_STAGE(PG8_SA(1, 0), a3, voffA);
            PG8_WAIT_V(8); PG8_WAIT_L(0); PG8_BAR; PG8_MMA(1, 0, At, B0); PG8_MMA(1, 1, At, B1); PG8_BAR; PG8_SCHED;
            } else {
            PG8_LDB(B0, 0, 0); PG8_SCHED; PG8_LDA(At, 0, 0); PG8_STAGE(PG8_SA(1, 1), a1 + hstep, voffA);
            PG8_WAIT_L(8); PG8_BAR; PG8_WAIT_L(0); PG8_MMA(0, 0, At, B0); PG8_BAR; PG8_SCHED;
            PG8_LDB(B1, 0, 1); PG8_STAGE(PG8_SB(0, 0), b2, voffB);
            PG8_BAR; PG8_WAIT_L(0); PG8_MMA(0, 1, At, B1); PG8_BAR;
            PG8_LDA(At, 0, 1); PG8_STAGE(PG8_SA(0, 0), a2, voffA);
            PG8_BAR; PG8_WAIT_L(0); PG8_MMA(1, 0, At, B0); PG8_BAR; PG8_SCHED;
            PG8_STAGE(PG8_SB(0, 1), b2 + hstep, voffB);
            PG8_WAIT_V(6); PG8_BAR; PG8_MMA(1, 1, At, B1); PG8_BAR;
            PG8_LDB(B0, 1, 0); PG8_SCHED; PG8_LDA(At, 1, 0); PG8_STAGE(PG8_SA(0, 1), a2 + hstep, voffA);
            PG8_WAIT_L(8); PG8_BAR; PG8_WAIT_L(0); PG8_MMA(0, 0, At, B0); PG8_BAR; PG8_SCHED;
            PG8_LDB(B1, 1, 1); PG8_STAGE(PG8_SB(1, 0), b3, voffB);
            PG8_BAR; PG8_WAIT_L(0); PG8_MMA(0, 1, At, B1); PG8_BAR;
            PG8_LDA(At, 1, 1); PG8_STAGE(PG8_SA(1, 0), a3, voffA);
            PG8_BAR; PG8_WAIT_L(0); PG8_MMA(1, 0, At, B0); PG8_BAR; PG8_SCHED;
            PG8_STAGE(PG8_SB(1, 1), b3 + hstep, voffB);
            PG8_WAIT_V(6); PG8_BAR; PG8_MMA(1, 1, At, B1); PG8_BAR;
            }
        }
        if constexpr (ALIGN_EPI) { if (wr == 0) PG8_BAR; }
        if constexpr (!Epi::AFTER_DRAIN) { E(acc, cur, wr, wc, fr, fq); S.done(cur); }
        if (!has_next) break;
#pragma unroll
        for (int a = 0; a < 2; ++a)
#pragma unroll
            for (int b = 0; b < 2; ++b)
#pragma unroll
                for (int m = 0; m < 4; ++m)
#pragma unroll
                    for (int n = 0; n < 2; ++n) acc[a][b][m][n] = (f32x4){0.f, 0.f, 0.f, 0.f};
        cur = nxt; cA = nA; cB = nB; ++ui;
        if constexpr (ALIGN_EPI) { if (wr == 1) PG8_BAR; }
    }
    PG8_WAIT_V(0);
    if constexpr (!ALIGN_EPI) { if (wr == 0) PG8_BAR; }
    PG8_BAR;
    if constexpr (Epi::AFTER_DRAIN) { E.fused(acc, cur, wr, wc, fr, fq, lds, wid, lane); S.done(cur); }
#undef PG8_SA
#undef PG8_SB
#undef PG8_STAGE
#undef PG8_LDA
#undef PG8_LDB
#undef PG8_MMA
#undef PG8_WAIT_V
#undef PG8_WAIT_L
#undef PG8_BAR
#undef PG8_SCHED
}
}
typedef unsigned short bf16_t;
typedef short bf16x8 __attribute__((ext_vector_type(8)));
typedef short s16x4 __attribute__((ext_vector_type(4)));
typedef float f32x4 __attribute__((ext_vector_type(4)));
typedef float f32x16 __attribute__((ext_vector_type(16)));
typedef unsigned u32x4 __attribute__((ext_vector_type(4)));
typedef unsigned u32x2 __attribute__((ext_vector_type(2)));
#define LAS __attribute__((address_space(3)))
constexpr int NTOK = 32768, DM = 1024, DFF = 2816, PW = 2560, SEQ = 4096, NBATCH = 8, NLAYER = 2;
constexpr int AQ = 0, AK = 512, AV = 1024, BQ = 1536, BK = 1792, BV = 1920, CQ = 2048, CK = 2304, CV = 2432;
constexpr float EPS = 1e-6f;
constexpr float QSCALE = 0.125f * 1.4426950408889634f;
constexpr int NWAVES = 8, NTHREADS = 512;
constexpr int LDS_BYTES = 147456;
constexpr size_t MiB = 1u << 20;
constexpr size_t WS_COS1 = 1 * MiB, WS_SIN1 = WS_COS1 + 512 * 1024, WS_COSX = 2 * MiB, WS_SINX = WS_COSX + 4096;
constexpr size_t WS_W = 4 * MiB, W_LAYER = 40 * MiB;
constexpr size_t WO_GU1 = 0, WO_D1 = 11 * MiB, WO_IN = WO_D1 + 5 * MiB + 512 * 1024, WO_OUT = WO_IN + 5 * MiB, WO_GU2 = WO_OUT + 2 * MiB, WO_D2 = WO_GU2 + 11 * MiB;
static_assert(WO_D2 + 5 * MiB + 512 * 1024 == W_LAYER, "weights per layer");
constexpr size_t WS_H = 84 * MiB, WS_U = 148 * MiB, WS_PROJ = WS_U, WS_ATTA = 324 * MiB, WS_ATTB = 420 * MiB, WS_ATTC = 436 * MiB, WS_LA = 452 * MiB, WS_END = 468 * MiB;
constexpr size_t WS_SS = 456 * MiB;
constexpr size_t WS_RS = 3 * MiB;
constexpr size_t WS_CAT = WS_PROJ;

__device__ __forceinline__ unsigned f2bf(float f) { unsigned u = __builtin_bit_cast(unsigned, f); return (u + 0x7fffu + ((u >> 16) & 1u)) >> 16; }
__device__ __forceinline__ unsigned pk2(float lo, float hi) { return f2bf(lo) | (f2bf(hi) << 16); }
__device__ __forceinline__ float bf2f(unsigned short b) { return __builtin_bit_cast(float, (unsigned)b << 16); }
__device__ __forceinline__ float bflo(unsigned w) { return __builtin_bit_cast(float, w << 16); }
__device__ __forceinline__ float bfhi(unsigned w) { return __builtin_bit_cast(float, w & 0xffff0000u); }
__device__ __forceinline__ float wave_sum(float v) {
#pragma unroll
    for (int o = 1; o < 64; o <<= 1) v += __shfl_xor(v, o);
    return v;
}
__device__ __forceinline__ float wave_max(float v) {
#pragma unroll
    for (int o = 1; o < 64; o <<= 1) v = fmaxf(v, __shfl_xor(v, o));
    return v;
}

__device__ __forceinline__ int fresh_tid(int wave0) { return wave0 * 64 + lane_id_fresh(); }
__device__ __forceinline__ int pax(int e) { return 8 * ((e & 15) >> 2) + 4 * (e >> 4) + (e & 3); }
__device__ __forceinline__ void transpose_item(const float* W, int K, int N, bf16_t* WT, int rbase, bool axial, const float* gk, LAS float* scr, int kb, int nb, int lane, float wsc = 1.0f) {
    const int k0 = 64 * kb, n0 = 32 * nb;
#pragma unroll 8
    for (int i = 0; i < 32; ++i) { const int kk = 2 * i + (lane >> 5); scr[kk * 33 + (lane & 31)] = W[(size_t)(k0 + kk) * N + n0 + (lane & 31)]; }
    asm volatile("s_waitcnt lgkmcnt(0)" ::: "memory");
    const int c = lane & 7;
    f32x4 g0 = {1.f, 1.f, 1.f, 1.f}, g1 = g0;
    if (gk) { g0 = *(const f32x4*)(gk + k0 + 8 * c) * wsc; g1 = *(const f32x4*)(gk + k0 + 8 * c + 4) * wsc; }
#pragma unroll
    for (int j = 0; j < 4; ++j) { const int n = (lane >> 3) + 8 * j; const LAS float* s = scr + (8 * c) * 33 + n;
        u32x4 o; o.x = pk2(s[0 * 33] * g0.x, s[1 * 33] * g0.y); o.y = pk2(s[2 * 33] * g0.z, s[3 * 33] * g0.w); o.z = pk2(s[4 * 33] * g1.x, s[5 * 33] * g1.y); o.w = pk2(s[6 * 33] * g1.z, s[7 * 33] * g1.w);
        const int r = rbase + (axial ? pax(n) : n);
        *(u32x4*)(WT + (size_t)r * K + k0 + 8 * c) = o; }
    asm volatile("s_waitcnt lgkmcnt(0)" ::: "memory");
}
__device__ __forceinline__ void transpose_matrix(const float* W, int K, int N, bf16_t* WT, int mode, const float* gk, LAS float* scr, int gw, int NGW, int lane) {
    const int nblk = N / 32, nitems = (K / 64) * nblk;
    for (int it = gw; it < nitems; it += NGW) {
        const int kb = it / nblk, nb = it % nblk; const int n0 = nb * 32;
        int rbase = n0; bool axial = false;
        if (mode == 1 || mode == 2) rbase = n0 + (n0 >> 7) * 128 + (mode == 2 ? 128 : 0);
        else if (mode == 3) { const int h = n0 >> 6, half = (n0 >> 5) & 1; rbase = 256 * (h >> 2) + 128 * half + 32 * (h & 3); axial = (h >= 24 && h < 30); }
        transpose_item(W, K, N, WT, rbase, axial, gk, scr, kb, nb, lane, mode == 1 ? -1.4426950408889634f : 1.0f);
    }
}
__device__ __forceinline__ void x_prep(const float* x, bf16_t* XB, float* ss, int gw, int NGW, int lane) {
    for (int m = gw; m < NTOK; m += NGW) {
        const f32x4* xr = (const f32x4*)(x + (size_t)m * DM) + lane; f32x4 v[4]; float s = 0.f;
#pragma unroll
        for (int j = 0; j < 4; ++j) { v[j] = xr[64 * j]; s += (v[j].x * v[j].x + v[j].y * v[j].y) + (v[j].z * v[j].z + v[j].w * v[j].w); }
        s = wave_sum(s);
        u32x2* o = (u32x2*)(XB + (size_t)m * DM) + lane;
#pragma unroll
        for (int j = 0; j < 4; ++j) { u32x2 w; w.x = pk2(v[j].x, v[j].y); w.y = pk2(v[j].z, v[j].w); o[64 * j] = w; }
        if (lane == 0) ss[m] = 1.0f / sqrtf(s * (1.0f / DM) + EPS);
    }
}
__device__ __forceinline__ void sincos_rev(float ang, float& c, float& s) {
    double r = (double)ang * 0.15915494309189533577; r -= __builtin_rint(r);
    const float rf = (float)r; s = __builtin_amdgcn_sinf(rf); c = __builtin_amdgcn_cosf(rf);
}
__device__ __forceinline__ void rope_tables(float* cos1, float* sin1, float* cosx, float* sinx, int gtid, int NGT) {
    for (int i = gtid; i < SEQ * 32; i += NGT) { const int t = i >> 5, j = i & 31;
        const float inv = 1.0f / __builtin_powf(10000.0f, (float)(2 * j) / 64.0f); const float ang = (float)t * inv; float c, s; sincos_rev(ang, c, s); cos1[i] = c; sin1[i] = s; }
    for (int i = gtid; i < 64 * 16; i += NGT) { const int p = i >> 4, j = i & 15;
        const float inv = 1.0f / __builtin_powf(10000.0f, (float)(2 * j) / 32.0f); const float ang = (float)p * inv; float c, s; sincos_rev(ang, c, s); cosx[i] = c; sinx[i] = s; }
}

__device__ __forceinline__ unsigned cvtpk(float lo, float hi) { typedef float f2 __attribute__((ext_vector_type(2))); typedef __bf16 b2 __attribute__((ext_vector_type(2)));
    f2 v = {lo, hi}; b2 b = __builtin_convertvector(v, b2); return __builtin_bit_cast(unsigned, b); }
typedef short v4i16_t __attribute__((ext_vector_type(4)));
__device__ __forceinline__ s16x4 vtr(LAS const unsigned char* p) { return __builtin_bit_cast(s16x4, __builtin_amdgcn_ds_read_tr16_b64_v4i16((LAS v4i16_t*)p)); }
__device__ __forceinline__ int crow(int r, int hi) { return (r & 3) + 8 * (r >> 2) + 4 * hi; }

#define SBAR() __builtin_amdgcn_sched_barrier(0)
__device__ __forceinline__ void k_load(LAS const unsigned char* kb, int r32, int hi, bf16x8 (&kf)[8]) {
#pragma unroll
    for (int d0 = 0; d0 < 4; ++d0) { const int c = 2 * d0 + hi;
        kf[2 * d0] = *(LAS const bf16x8*)(kb + c * 1024 + ((r32 ^ c) * 16));
        kf[2 * d0 + 1] = *(LAS const bf16x8*)(kb + c * 1024 + 512 + ((r32 ^ c) * 16)); }
}
__device__ __forceinline__ void qk_mma(const bf16x8 (&kf)[8], const bf16x8 (&qf)[4], f32x16& s0, f32x16& s1) {
    const f32x16 z = {0.f, 0.f, 0.f, 0.f, 0.f, 0.f, 0.f, 0.f, 0.f, 0.f, 0.f, 0.f, 0.f, 0.f, 0.f, 0.f};
    s0 = __builtin_amdgcn_mfma_f32_32x32x16_bf16(kf[0], qf[0], z, 0, 0, 0); s1 = __builtin_amdgcn_mfma_f32_32x32x16_bf16(kf[1], qf[0], z, 0, 0, 0);
#pragma unroll
    for (int d0 = 1; d0 < 4; ++d0) { s0 = __builtin_amdgcn_mfma_f32_32x32x16_bf16(kf[2 * d0], qf[d0], s0, 0, 0, 0); s1 = __builtin_amdgcn_mfma_f32_32x32x16_bf16(kf[2 * d0 + 1], qf[d0], s1, 0, 0, 0); }
}
__device__ __forceinline__ void v_load(LAS const unsigned char* vb, s16x4 (&vf)[16]) {
#pragma unroll
    for (int s = 0; s < 4; ++s)
#pragma unroll
        for (int d0 = 0; d0 < 2; ++d0) { vf[4 * s + 2 * d0] = vtr(vb + d0 * 4096 + s * 1024); vf[4 * s + 2 * d0 + 1] = vtr(vb + d0 * 4096 + s * 1024 + 512); }
}
__device__ __forceinline__ void pv_mma(const s16x4 (&vf)[16], const u32x4 (&pw)[4], f32x16 (&o)[2]) {
#pragma unroll
    for (int s = 0; s < 4; ++s)
#pragma unroll
        for (int d0 = 0; d0 < 2; ++d0) { const s16x4 lo = vf[4 * s + 2 * d0], hh = vf[4 * s + 2 * d0 + 1];
            const bf16x8 v = (bf16x8){lo[0], lo[1], lo[2], lo[3], hh[0], hh[1], hh[2], hh[3]};
            o[d0] = __builtin_amdgcn_mfma_f32_32x32x16_bf16(v, __builtin_bit_cast(bf16x8, pw[s]), o[d0], 0, 0, 0); }
}
template <bool BAND, bool SHIFT>
__device__ __forceinline__ void softmax_tile(f32x16& s0, f32x16& s1, bool full, int base, int radius, float negshift, float& lsum, u32x4 (&pw)[4]) {
    if (SHIFT) {
#pragma unroll
        for (int r = 0; r < 16; ++r) { s0[r] += negshift; s1[r] += negshift; } }
#pragma unroll
    for (int r = 0; r < 16; ++r) { s0[r] = __builtin_amdgcn_exp2f(s0[r]); s1[r] = __builtin_amdgcn_exp2f(s1[r]); }
    if (BAND) { if (!full) {
#pragma unroll
        for (int r = 0; r < 16; ++r) { const int d = base + (r & 3) + 8 * (r >> 2); const int d1 = d + 32;
            if (d > radius || d < -radius) s0[r] = 0.f;
            if (d1 > radius || d1 < -radius) s1[r] = 0.f; } } }
    {   float t[8];
#pragma unroll
        for (int i = 0; i < 8; ++i) t[i] = (s0[i] + s0[i + 8]) + (s1[i] + s1[i + 8]);
        lsum += ((t[0] + t[1]) + (t[2] + t[3])) + ((t[4] + t[5]) + (t[6] + t[7])); }
#pragma unroll
    for (int s = 0; s < 2; ++s) {
        pw[s] = (u32x4){cvtpk(s0[8 * s + 0], s0[8 * s + 1]), cvtpk(s0[8 * s + 2], s0[8 * s + 3]), cvtpk(s0[8 * s + 4], s0[8 * s + 5]), cvtpk(s0[8 * s + 6], s0[8 * s + 7])};
        pw[2 + s] = (u32x4){cvtpk(s1[8 * s + 0], s1[8 * s + 1]), cvtpk(s1[8 * s + 2], s1[8 * s + 3]), cvtpk(s1[8 * s + 4], s1[8 * s + 5]), cvtpk(s1[8 * s + 6], s1[8 * s + 7])};
    }
}
template <bool BAND, bool SHIFT>
__device__ __forceinline__ void attn_core(LAS unsigned char* lds, const bf16_t* Kp, const bf16_t* Vp, size_t kvstride, const bf16_t* Qp, size_t qstride,
                                          int qslot0, int t_lo, int t_hi, int radius, float negshift, f32x16 (&o)[2], float& lsum, const int wave0) {
    const int tid = fresh_tid(wave0), lane = tid & 63, r32 = lane & 31, hi = lane >> 5;
    const int srow = tid >> 3, sch = tid & 7;
    bf16x8 qf[4];
#pragma unroll
    for (int d0 = 0; d0 < 4; ++d0) qf[d0] = *(const bf16x8*)(Qp + (size_t)r32 * qstride + d0 * 16 + hi * 8);
#pragma unroll
    for (int r = 0; r < 16; ++r) { o[0][r] = 0.f; o[1][r] = 0.f; }
    lsum = 0.f;
    const unsigned kw = (unsigned)(sch * 1024 + ((srow ^ sch) * 16));
    const unsigned vw = (unsigned)(16384 + (sch >> 2) * 4096 + (srow >> 4) * 1024 + (srow & 15) * 64 + (sch & 3) * 16);
    const unsigned voff = (unsigned)(((lane >> 4) & 1) * 32 + (lane & 3) * 8 + (4 * hi + ((lane & 15) >> 2)) * 64);
    const bf16_t* kg = Kp + (size_t)srow * kvstride + sch * 8;
    const bf16_t* vg = Vp + (size_t)srow * kvstride + sch * 8;
    const int tlast = t_hi - 1;
    const int n_it = (t_hi - t_lo + 1) >> 1;
    u32x4 kr0, vr0, kr1, vr1;
    { const size_t o0 = (size_t)(t_lo * 64) * kvstride; const int tb = (t_lo + 1 < t_hi) ? t_lo + 1 : tlast; const size_t o1 = (size_t)(tb * 64) * kvstride;
      kr0 = *(const u32x4*)(kg + o0); vr0 = *(const u32x4*)(vg + o0); kr1 = *(const u32x4*)(kg + o1); vr1 = *(const u32x4*)(vg + o1); }
    *(LAS u32x4*)(lds + kw) = kr0; *(LAS u32x4*)(lds + 8192 + kw) = kr1; *(LAS u32x4*)(lds + vw) = vr0; *(LAS u32x4*)(lds + 8192 + vw) = vr1;
    __syncthreads();
    for (int it = 0; it < n_it; ++it) {
        const unsigned bo = (unsigned)((it & 1) * 32768);
        const bool more = (it + 1 < n_it);
        const int tA = t_lo + 2 * it, tB = tA + 1;
        if (more) { const int ta = tA + 2; const int tb = (ta + 1 < t_hi) ? ta + 1 : tlast; const size_t o0 = (size_t)(ta * 64) * kvstride, o1 = (size_t)(tb * 64) * kvstride;
            kr0 = *(const u32x4*)(kg + o0); vr0 = *(const u32x4*)(vg + o0); kr1 = *(const u32x4*)(kg + o1); vr1 = *(const u32x4*)(vg + o1); }
        bool actA = true, actB = (tB < t_hi), fullA = true, fullB = true;
        const int kvA = tA * 64, kvB = tB * 64;
        if (BAND) {
            actA = !(kvA > qslot0 + 31 + radius || kvA + 63 < qslot0 - radius);
            actB = actB && !(kvB > qslot0 + 31 + radius || kvB + 63 < qslot0 - radius);
            fullA = (kvA >= qslot0 + 31 - radius) && (kvA + 63 <= qslot0 + radius);
            fullB = (kvB >= qslot0 + 31 - radius) && (kvB + 63 <= qslot0 + radius);
        }
        LAS const unsigned char* kbA = lds + bo; LAS const unsigned char* kbB = lds + bo + 8192;
        LAS const unsigned char* vbA = lds + bo + 16384 + voff; LAS const unsigned char* vbB = lds + bo + 24576 + voff;
        const int baseA = kvA + 4 * hi - (qslot0 + r32), baseB = baseA + 64;
        if (!BAND) {
            f32x16 a0, a1, b0, b1; u32x4 pa[4], pb[4]; s16x4 vfa[16], vfb[16]; bf16x8 kfa[8], kfb[8];
            k_load(kbA, r32, hi, kfa); SBAR();
            qk_mma(kfa, qf, a0, a1); v_load(vbA, vfa); k_load(kbB, r32, hi, kfb); SBAR();
            qk_mma(kfb, qf, b0, b1);
            softmax_tile<BAND, SHIFT>(a0, a1, true, 0, 0, negshift, lsum, pa);
#pragma unroll
            for (int i = 0; i < 8; ++i) { __builtin_amdgcn_sched_group_barrier(0x008, 1, 0); __builtin_amdgcn_sched_group_barrier(0x402, 9, 0); }
            SBAR();
            if (more) { const unsigned nb = bo ^ 32768u; *(LAS u32x4*)(lds + nb + kw) = kr0; *(LAS u32x4*)(lds + nb + 8192 + kw) = kr1; *(LAS u32x4*)(lds + nb + vw) = vr0; *(LAS u32x4*)(lds + nb + 8192 + vw) = vr1; }
            v_load(vbB, vfb); SBAR();
            pv_mma(vfa, pa, o);
            softmax_tile<BAND, SHIFT>(b0, b1, true, 0, 0, negshift, lsum, pb);
#pragma unroll
            for (int i = 0; i < 8; ++i) { __builtin_amdgcn_sched_group_barrier(0x008, 1, 0); __builtin_amdgcn_sched_group_barrier(0x402, 9, 0); }
            SBAR();
            pv_mma(vfb, pb, o); SBAR();
        } else {
#pragma unroll 1
            for (int h = 0; h < 2; ++h) {
                const bool act = h ? actB : actA;
                if (act) {
                    f32x16 a0, a1; u32x4 pa[4]; s16x4 vf[16]; bf16x8 kf[8];
                    LAS const unsigned char* kb1 = h ? kbB : kbA; LAS const unsigned char* vb1 = h ? vbB : vbA;
                    k_load(kb1, r32, hi, kf); SBAR(); qk_mma(kf, qf, a0, a1); SBAR();
                    v_load(vb1, vf); SBAR();
                    softmax_tile<BAND, SHIFT>(a0, a1, h ? fullB : fullA, h ? baseB : baseA, radius, negshift, lsum, pa);
                    SBAR(); pv_mma(vf, pa, o); SBAR();
                }
            }
        }
        if (BAND && more) { const unsigned nb = bo ^ 32768u; *(LAS u32x4*)(lds + nb + kw) = kr0; *(LAS u32x4*)(lds + nb + 8192 + kw) = kr1; *(LAS u32x4*)(lds + nb + vw) = vr0; *(LAS u32x4*)(lds + nb + 8192 + vw) = vr1; }
        __syncthreads();
    }
}
__device__ __forceinline__ void store_o(LAS unsigned char* stg, bf16_t* orow0, size_t ostride, const f32x16 (&o)[2], float sc, int lane) {
    const int r32 = lane & 31, hi = lane >> 5;
#pragma unroll
    for (int d0 = 0; d0 < 2; ++d0)
#pragma unroll
        for (int g = 0; g < 4; ++g) { u32x2 w; w.x = cvtpk(o[d0][4 * g] * sc, o[d0][4 * g + 1] * sc); w.y = cvtpk(o[d0][4 * g + 2] * sc, o[d0][4 * g + 3] * sc);
            const int ch = 4 * d0 + g; *(LAS u32x2*)(stg + r32 * 128 + ((ch ^ (r32 & 7)) * 16) + hi * 8) = w; }
#pragma unroll
    for (int p = 0; p < 4; ++p) { const int row = 8 * p + (lane >> 3), ci = lane & 7;
        const u32x4 v = *(LAS const u32x4*)(stg + row * 128 + ((ci ^ (row & 7)) * 16));
        *(u32x4*)(orow0 + (size_t)row * ostride + ci * 8) = v; }
}
struct BandUnit { const bf16_t* Kp; const bf16_t* Vp; const bf16_t* Qp; size_t stride; bf16_t* orow0; float* lrow0; int ostride, lstride; int qslot0, t_lo, t_hi, radius; float negshift, lextra, isC; };
__device__ __forceinline__ void band_issue(const BandUnit& u, int srow, int sch, u32x4 (&st)[12], bf16x8 (&qf)[4], int r32, int hi) {
#pragma unroll
    for (int j = 0; j < 6; ++j) { int t = u.t_lo + j; if (t > u.t_hi - 1) t = u.t_hi - 1;
        const size_t off = (size_t)(t * 64 + srow) * u.stride + sch * 8;
        st[2 * j] = *(const u32x4*)(u.Kp + off); st[2 * j + 1] = *(const u32x4*)(u.Vp + off); }
#pragma unroll
    for (int d0 = 0; d0 < 4; ++d0) qf[d0] = *(const bf16x8*)(u.Qp + (size_t)r32 * u.stride + d0 * 16 + hi * 8);
}
__device__ __forceinline__ void band_compute(LAS unsigned char* lds, const BandUnit& u, const bf16x8 (&qf)[4], int r32, int hi, unsigned voff, f32x16 (&o)[2], float& lsum) {
#pragma unroll
    for (int r = 0; r < 16; ++r) { o[0][r] = 0.f; o[1][r] = 0.f; }
    lsum = 0.f;
#pragma unroll 1
    for (int jh = 0; jh < 12; ++jh) {
        const int t = u.t_lo + (jh >> 1), hh = jh & 1; const int kv0 = t * 64 + 32 * hh;
        const bool act = (t < u.t_hi) && !(kv0 > u.qslot0 + 31 + u.radius || kv0 + 31 < u.qslot0 - u.radius);
        if (act) {
            const bool full = (kv0 >= u.qslot0 + 31 - u.radius) && (kv0 + 31 <= u.qslot0 + u.radius);
            const int base = kv0 + 4 * hi - (u.qslot0 + r32);
            LAS const unsigned char* kb = lds + (jh >> 1) * 16384 + hh * 512; LAS const unsigned char* vb = lds + (jh >> 1) * 16384 + 8192 + voff + hh * 2048;
            bf16x8 kf[4]; s16x4 vf[8]; f32x16 sa;
#pragma unroll
            for (int d0 = 0; d0 < 4; ++d0) { const int c = 2 * d0 + hi; kf[d0] = *(LAS const bf16x8*)(kb + c * 1024 + ((r32 ^ c) * 16)); }
            SBAR();
            { const f32x16 z = {0.f, 0.f, 0.f, 0.f, 0.f, 0.f, 0.f, 0.f, 0.f, 0.f, 0.f, 0.f, 0.f, 0.f, 0.f, 0.f};
              sa = __builtin_amdgcn_mfma_f32_32x32x16_bf16(kf[0], qf[0], z, 0, 0, 0);
#pragma unroll
              for (int d0 = 1; d0 < 4; ++d0) sa = __builtin_amdgcn_mfma_f32_32x32x16_bf16(kf[d0], qf[d0], sa, 0, 0, 0); }
            SBAR();
#pragma unroll
            for (int s = 0; s < 2; ++s)
#pragma unroll
                for (int d0 = 0; d0 < 2; ++d0) { vf[4 * s + 2 * d0] = vtr(vb + d0 * 4096 + s * 1024); vf[4 * s + 2 * d0 + 1] = vtr(vb + d0 * 4096 + s * 1024 + 512); }
            SBAR();
            if (u.negshift != 0.f) {
#pragma unroll
                for (int r = 0; r < 16; ++r) sa[r] += u.negshift; }
#pragma unroll
            for (int r = 0; r < 16; ++r) sa[r] = __builtin_amdgcn_exp2f(sa[r]);
            if (!full) {
                if (kv0 + 31 > u.qslot0 + u.radius) { const int thr = u.radius - base;
#pragma unroll
                    for (int r = 0; r < 16; ++r) { if ((r & 3) + 8 * (r >> 2) > thr) sa[r] = 0.f; } }
                else { const int thr = -u.radius - base;
#pragma unroll
                    for (int r = 0; r < 16; ++r) { if ((r & 3) + 8 * (r >> 2) < thr) sa[r] = 0.f; } } }
            lsum += (((sa[0] + sa[8]) + (sa[1] + sa[9])) + ((sa[2] + sa[10]) + (sa[3] + sa[11]))) + (((sa[4] + sa[12]) + (sa[5] + sa[13])) + ((sa[6] + sa[14]) + (sa[7] + sa[15])));
            u32x4 pw[2];
#pragma unroll
            for (int s = 0; s < 2; ++s) pw[s] = (u32x4){cvtpk(sa[8 * s + 0], sa[8 * s + 1]), cvtpk(sa[8 * s + 2], sa[8 * s + 3]), cvtpk(sa[8 * s + 4], sa[8 * s + 5]), cvtpk(sa[8 * s + 6], sa[8 * s + 7])};
            SBAR();
#pragma unroll
            for (int s = 0; s < 2; ++s)
#pragma unroll
                for (int d0 = 0; d0 < 2; ++d0) { const s16x4 lo = vf[4 * s + 2 * d0], hh2 = vf[4 * s + 2 * d0 + 1];
                    const bf16x8 v = (bf16x8){lo[0], lo[1], lo[2], lo[3], hh2[0], hh2[1], hh2[2], hh2[3]};
                    o[d0] = __builtin_amdgcn_mfma_f32_32x32x16_bf16(v, __builtin_bit_cast(bf16x8, pw[s]), o[d0], 0, 0, 0); }
            SBAR();
        }
    }
}
struct AttnArgs { const bf16_t* P; bf16_t* OA; bf16_t* OB; bf16_t* OC; float* LA; const float *aqn, *akn, *bqn, *bkn, *cqn, *ckn, *sink; };
__device__ __forceinline__ BandUnit band_decode(const AttnArgs& A, int idx, int wave, float shA, float shC0) {
    const float L2E = 1.4426950408889634f;
    BandUnit u;
    if (idx < 1024) {
        const int j0 = idx & 511; const int cc = j0 & 255, pass = j0 >> 8;
        const int pair = (cc & 7) + 8 * pass; const int batch = pair >> 1, g = pair & 1, qb = cc >> 3;
        const int r = wave >> 2, sub = wave & 3, qh = 2 * g + r;
        u.qslot0 = qb * 128 + sub * 32;
        const bf16_t* base = A.P + (size_t)batch * SEQ * PW;
        u.Qp = base + (size_t)u.qslot0 * PW + CQ + qh * 64; u.Kp = base + CK + g * 64; u.Vp = base + CV + g * 64; u.stride = PW;
        const float sk = A.sink[qh] * L2E; const float sh = (sk > 64.f || shC0 != 0.f) ? fmaxf(shC0, sk) : 0.f;
        u.negshift = -sh; u.lextra = __builtin_amdgcn_exp2f(sk - sh); u.isC = 1.f; u.radius = 128;
        int t_lo = 2 * qb - 2, t_hi = 2 * qb + 4; if (t_lo < 0) t_lo = 0; if (t_hi > 64) t_hi = 64; u.t_lo = t_lo; u.t_hi = t_hi;
        u.orow0 = A.OC + ((size_t)batch * SEQ + u.qslot0) * 256 + qh * 64; u.lrow0 = nullptr; u.ostride = 256; u.lstride = 0;
    } else {
        const int j = idx - 1024; const int cc = j & 255, pass = j >> 8, jx = cc >> 3;
        const int st = (cc & 7) + 8 * (2 * pass + (jx >> 4));
        const int br = st >> 6, batch = (st >> 3) & 7, head = st & 7, blk = jx & 15;
        const int dil = br == 0 ? 1 : (br == 1 ? 4 : 16); const int nbr = 16 / dil;
        const int res = blk / nbr, sb = blk % nbr; const int slot0 = sb * 256; const int L = SEQ / dil;
        u.qslot0 = slot0 + 32 * wave;
        const bf16_t* base = A.P + ((size_t)batch * SEQ + res) * PW;
        u.stride = (size_t)dil * PW;
        u.Qp = base + (size_t)u.qslot0 * u.stride + AQ + head * 64; u.Kp = base + AK + head * 64; u.Vp = base + AV + head * 64;
        int t_lo = slot0 / 64 - 1, t_hi = slot0 / 64 + 5; if (t_lo < 0) t_lo = 0; if (t_hi > L / 64) t_hi = L / 64; u.t_lo = t_lo; u.t_hi = t_hi;
        u.negshift = -shA; u.lextra = 0.f; u.isC = 0.f; u.radius = 64;
        const size_t tok = (size_t)batch * SEQ + (size_t)u.qslot0 * dil + res;
        u.orow0 = A.OA + ((size_t)br * NTOK + tok) * 512 + head * 64; u.lrow0 = A.LA + ((size_t)br * NTOK + tok) * 8 + head; u.ostride = dil * 512; u.lstride = dil * 8;
    }
    return u;
}
__device__ __forceinline__ void attn_phase(LAS unsigned char* lds, const AttnArgs& A, int wg, int NWG, int wave, int lane) {
    const int r32 = lane & 31, hi = lane >> 5;
    const float L2E = 1.4426950408889634f;
    float shA = 8.0f * wave_max(fabsf(A.aqn[lane])) * wave_max(fabsf(A.akn[lane])) * L2E; if (shA < 64.f) shA = 0.f;
    float shB = 8.0f * wave_max(fabsf(A.bqn[lane])) * wave_max(fabsf(A.bkn[lane])) * L2E; if (shB < 64.f) shB = 0.f;
    float shC0 = 8.0f * wave_max(fabsf(A.cqn[lane])) * wave_max(fabsf(A.ckn[lane])) * L2E; if (shC0 < 64.f) shC0 = 0.f;
    shA = __builtin_bit_cast(float, __builtin_amdgcn_readfirstlane(__builtin_bit_cast(int, shA)));
    shB = __builtin_bit_cast(float, __builtin_amdgcn_readfirstlane(__builtin_bit_cast(int, shB)));
    shC0 = __builtin_bit_cast(float, __builtin_amdgcn_readfirstlane(__builtin_bit_cast(int, shC0)));
    for (int idx = wg; idx < 512; idx += NWG) {
        f32x16 o[2]; float lsum;
        const int cc = idx & 255, pass = idx >> 8;
        const int pair = (cc & 7) + 8 * pass; const int batch = pair >> 1, g = pair & 1, qb = cc >> 3;
        const int r = wave >> 2, sub = wave & 3, qh = 2 * g + r;
        const int qslot0 = qb * 128 + sub * 32;
        const bf16_t* base = A.P + (size_t)batch * SEQ * PW;
        const bf16_t* Qp = base + (size_t)qslot0 * PW + BQ + qh * 64;
        const bf16_t* Kp = base + BK + g * 64;
        const bf16_t* Vp = base + BV + g * 64;
        if (shB != 0.f) attn_core<false, true>(lds, Kp, Vp, PW, Qp, PW, qslot0, 0, 64, 0, -shB, o, lsum, wave);
        else attn_core<false, false>(lds, Kp, Vp, PW, Qp, PW, qslot0, 0, 64, 0, 0.f, o, lsum, wave);
        const float l = lsum + __shfl_xor(lsum, 32);
        bf16_t* orow0 = A.OB + ((size_t)batch * SEQ + qslot0) * 256 + qh * 64;
        store_o(lds + 98304 + wave * 4096, orow0, 256, o, 1.0f / l, lane);
    }
    {
        const int lane = lane_id_fresh(), r32 = lane & 31, hi = lane >> 5;
        const int tid = wave * 64 + lane; const int srow = tid >> 3, sch = tid & 7;
        const unsigned kw = (unsigned)(sch * 1024 + ((srow ^ sch) * 16));
        const unsigned vw0 = (unsigned)(8192 + (sch >> 2) * 4096 + (srow >> 4) * 1024 + (srow & 15) * 64 + (sch & 3) * 16);
        const unsigned voff = (unsigned)(((lane >> 4) & 1) * 32 + (lane & 3) * 8 + (4 * hi + ((lane & 15) >> 2)) * 64);
        u32x4 st[12]; bf16x8 qn[4];
        int idx = 512 + wg;
        if (idx < 4096) { const BandUnit nu = band_decode(A, idx, wave, shA, shC0); band_issue(nu, srow, sch, st, qn, r32, hi); }
        for (; idx < 4096; idx += NWG) {
            const BandUnit u = band_decode(A, idx, wave, shA, shC0);
            bf16x8 qf[4];
#pragma unroll
            for (int d0 = 0; d0 < 4; ++d0) qf[d0] = qn[d0];
#pragma unroll
            for (int j = 0; j < 6; ++j) { *(LAS u32x4*)(lds + j * 16384 + kw) = st[2 * j]; *(LAS u32x4*)(lds + j * 16384 + vw0) = st[2 * j + 1]; }
            __syncthreads();
            if (idx + NWG < 4096) { const BandUnit nu = band_decode(A, idx + NWG, wave, shA, shC0); band_issue(nu, srow, sch, st, qn, r32, hi); }
            f32x16 o[2]; float lsum;
            band_compute(lds, u, qf, r32, hi, voff, o, lsum);
            const float l = lsum + __shfl_xor(lsum, 32) + u.lextra;
            store_o(lds + 98304 + wave * 4096, u.orow0, (size_t)u.ostride, o, (u.isC != 0.f) ? 1.0f / l : 1.0f, lane);
            if (u.isC == 0.f && hi == 0) u.lrow0[(size_t)r32 * u.lstride] = l;
            __syncthreads();
        }
    }
}
__device__ __forceinline__ void combine_phase(const bf16_t* OA, const float* LA, const bf16_t* OB, const bf16_t* OC, const float* gg, bf16_t* CAT, int gw, int NGW, int lane) {
    const f32x4 ga0 = ((const f32x4*)gg)[lane * 2], ga1 = ((const f32x4*)gg)[lane * 2 + 1];
    const f32x4 gb = ((const f32x4*)(gg + 512))[lane], gc = ((const f32x4*)(gg + 768))[lane];
    const int head = lane >> 3;
    for (int m0 = gw * 2; m0 < NTOK; m0 += NGW * 2) {
        u32x4 wa[2][3]; float la[2][3]; u32x2 wb[2], wc[2];
#pragma unroll
        for (int u = 0; u < 2; ++u) { const int m = m0 + u;
#pragma unroll
            for (int br = 0; br < 3; ++br) { la[u][br] = LA[((size_t)br * NTOK + m) * 8 + head]; wa[u][br] = *(const u32x4*)(OA + ((size_t)br * NTOK + m) * 512 + lane * 8); }
            wb[u] = *(const u32x2*)(OB + (size_t)m * 256 + lane * 4); wc[u] = *(const u32x2*)(OC + (size_t)m * 256 + lane * 4); }
#pragma unroll
        for (int u = 0; u < 2; ++u) { const int m = m0 + u;
            float v[8];
#pragma unroll
            for (int i = 0; i < 8; ++i) v[i] = 0.f;
#pragma unroll
            for (int br = 0; br < 3; ++br) { const u32x4 w = wa[u][br];
                v[0] += bflo(w.x); v[1] += bfhi(w.x); v[2] += bflo(w.y); v[3] += bfhi(w.y); v[4] += bflo(w.z); v[5] += bfhi(w.z); v[6] += bflo(w.w); v[7] += bfhi(w.w); }
            const float il = 1.0f / ((la[u][0] + la[u][1]) + la[u][2]); float ss = 0.f;
#pragma unroll
            for (int i = 0; i < 8; ++i) { v[i] *= il; ss += v[i] * v[i]; }
            const float b0 = bflo(wb[u].x), b1 = bfhi(wb[u].x), b2 = bflo(wb[u].y), b3 = bfhi(wb[u].y);
            const float c0 = bflo(wc[u].x), c1 = bfhi(wc[u].x), c2 = bflo(wc[u].y), c3 = bfhi(wc[u].y);
            float sb = (b0 * b0 + b1 * b1) + (b2 * b2 + b3 * b3), sc = (c0 * c0 + c1 * c1) + (c2 * c2 + c3 * c3);
#pragma unroll
            for (int o = 1; o < 64; o <<= 1) { ss += __shfl_xor(ss, o); sb += __shfl_xor(sb, o); sc += __shfl_xor(sc, o); }
            const float ra = 1.0f / sqrtf(ss * (1.0f / 512.0f) + EPS), rb = 1.0f / sqrtf(sb * (1.0f / 256.0f) + EPS), rc = 1.0f / sqrtf(sc * (1.0f / 256.0f) + EPS);
            u32x4 wo; wo.x = pk2(v[0] * ra * ga0.x, v[1] * ra * ga0.y); wo.y = pk2(v[2] * ra * ga0.z, v[3] * ra * ga0.w);
            wo.z = pk2(v[4] * ra * ga1.x, v[5] * ra * ga1.y); wo.w = pk2(v[6] * ra * ga1.z, v[7] * ra * ga1.w);
            *(u32x4*)(CAT + (size_t)m * DM + lane * 8) = wo;
            u32x2 q; q.x = pk2(b0 * rb * gb.x, b1 * rb * gb.y); q.y = pk2(b2 * rb * gb.z, b3 * rb * gb.w);
            *(u32x2*)(CAT + (size_t)m * DM + 512 + lane * 4) = q;
            u32x2 r; r.x = pk2(c0 * rc * gc.x, c1 * rc * gc.y); r.y = pk2(c2 * rc * gc.z, c3 * rc * gc.w);
            *(u32x2*)(CAT + (size_t)m * DM + 768 + lane * 4) = r;
        }
    }
}

#define GAS __attribute__((address_space(1)))
#define XB_TMO      128
#define XB_XCNT(j)  (256  + 64 * (j))
#define XB_XSUB(j)  (1280 + 64 * (j))
#define XB_XGEN(j)  (2304 + 64 * (j))
#define XB_TOP      3328
#define XB_TOPGEN   3392
#define XCD_BAR_WORDS 3456
#define XB_SPIN_CAP (1u << 18)

__device__ __forceinline__ unsigned xb_ld(unsigned* p)              { return __hip_atomic_load(p, __ATOMIC_RELAXED, __HIP_MEMORY_SCOPE_AGENT); }
__device__ __forceinline__ unsigned xb_add(unsigned* p, unsigned v) { return __hip_atomic_fetch_add(p, v, __ATOMIC_RELAXED, __HIP_MEMORY_SCOPE_AGENT); }
__device__ __forceinline__ unsigned xb_xcc_id() { return (unsigned)__builtin_amdgcn_s_getreg((3 << 11) | 20) & 0xFu; }
#define XB_SPIN(cond, bar) do { unsigned _sp = 0; while (cond) { __builtin_amdgcn_s_sleep(1); \
    if ((++_sp & 255u) == 0u) { if (xb_ld(&(bar)[XB_TMO])) break; if (_sp > XB_SPIN_CAP) { atomicAdd(&(bar)[XB_TMO], 1u); break; } } } } while (0)

struct XcdBarrier {
    unsigned* bar; unsigned x;
    volatile LAS unsigned* st;
};

__device__ __forceinline__ XcdBarrier xcd_barrier_post(unsigned* bar, volatile LAS unsigned* st, const int tid0) {
    XcdBarrier b; b.bar = bar; b.x = xb_xcc_id(); b.st = st;
    if (tid0 == 0) (void)xb_add(&bar[XB_XCNT(b.x)], 1u);
    return b;
}
__device__ __forceinline__ void xcd_barrier_complete(unsigned* bar, unsigned x, unsigned& nloc, unsigned& nx) {
    const unsigned G = gridDim.x * gridDim.y * gridDim.z;
    unsigned sum, cnt, mine, sp = 0u;
    for (;;) {
        sum = 0u; cnt = 0u; mine = 0u;
#pragma unroll
        for (unsigned j = 0; j < 16; ++j) { const unsigned c = xb_ld(&bar[XB_XCNT(j)]); sum += c; cnt += (c > 0u) ? 1u : 0u; mine = (j == x) ? c : mine; }
        if (sum == G) break;
        __builtin_amdgcn_s_sleep(1);
        if ((++sp & 255u) == 0u) { if (xb_ld(&bar[XB_TMO])) break; if (sp > XB_SPIN_CAP) { atomicAdd(&bar[XB_TMO], 1u); break; } }
    }
    nloc = mine > 0u ? mine : 1u; nx = cnt > 0u ? cnt : 1u;
}

__device__ __forceinline__ void xcd_barrier(const XcdBarrier& b, const int tid0) {
    asm volatile("s_waitcnt vmcnt(0)" ::: "memory");
    __syncthreads();
    if (tid0 == 0) {
        unsigned* bar = b.bar;
        __builtin_amdgcn_s_waitcnt(0);
        unsigned nloc = b.st[0], nx = b.st[1];
        if (nloc == 0u) { xcd_barrier_complete(bar, b.x, nloc, nx); b.st[0] = nloc; b.st[1] = nx; }
        const unsigned old = xb_add(&bar[XB_XSUB(b.x)], 1u);
        const unsigned gen = old / nloc;
        if (old + 1u == (gen + 1u) * nloc) {
            __builtin_amdgcn_fence(__ATOMIC_RELEASE, "agent");
            asm volatile("s_waitcnt vmcnt(0)" ::: "memory");
            const unsigned og = xb_add(&bar[XB_TOP], 1u);
            const unsigned tg = og / nx;
            if (og + 1u == (tg + 1u) * nx) xb_add(&bar[XB_TOPGEN], 1u);
            else XB_SPIN(xb_ld(&bar[XB_TOPGEN]) == tg, bar);
            __builtin_amdgcn_fence(__ATOMIC_ACQUIRE, "agent");
            xb_add(&bar[XB_XGEN(b.x)], 1u);
            asm volatile("s_waitcnt vmcnt(0)" ::: "memory");
        } else {
            XB_SPIN(xb_ld(&bar[XB_XGEN(b.x)]) == gen, bar);
            __builtin_amdgcn_fence(__ATOMIC_ACQUIRE, "agent");
            asm volatile("s_waitcnt vmcnt(0)" ::: "memory");
        }
    }
    __syncthreads();
}

__device__ __forceinline__ void finalize_rs(const float* ssp, float* rs, int gtid, int NGT) {
    for (int i = gtid; i < NTOK; i += NGT) { const f32x4* p = (const f32x4*)(ssp + (size_t)i * 16);
        const f32x4 a = p[0], b = p[1], c = p[2], d = p[3];
        const float s = (((a[0] + a[1]) + (a[2] + a[3])) + ((b[0] + b[1]) + (b[2] + b[3]))) + (((c[0] + c[1]) + (c[2] + c[3])) + ((d[0] + d[1]) + (d[2] + d[3])));
        rs[i] = 1.0f / sqrtf(s * (1.0f / DM) + EPS); }
}
struct Args { const float* in[20]; float* out; unsigned char* ws; };
typedef const volatile Args __attribute__((address_space(4))) * kargp_t;
#define KARG() ((kargp_t)__builtin_amdgcn_kernarg_segment_ptr())
#define LD_IN(i) ((const float*)KARG()->in[i])
#define LD_WS() ((unsigned char*)KARG()->ws)
#define LD_OUT() ((float*)KARG()->out)
__global__ void __launch_bounds__(NTHREADS, 2) fwd_megakernel(Args a_unused) {
    extern __shared__ __attribute__((aligned(16))) unsigned char lds_raw[];
    LAS unsigned char* lds = (LAS unsigned char*)lds_raw;
    cg::grid_group grid = cg::this_grid();
    const int G = gridDim.x, wg = blockIdx.x;
    const int NGW = G * NWAVES;
    const int wave0 = __builtin_amdgcn_readfirstlane(threadIdx.x >> 6);
#define FRESH() const int wave = fresh_wave(wave0), tid = fresh_tid(wave), lane = tid & 63, gw = wg * NWAVES + wave; (void)lane; (void)gw
    volatile LAS unsigned* bst = (volatile LAS unsigned*)(lds + 131072 + 512);
    {   unsigned* barw = (unsigned*)(LD_WS() + 0);
        if (threadIdx.x < 2) bst[threadIdx.x] = 0u;
        if (wg == 0) for (int i = threadIdx.x; i < XCD_BAR_WORDS; i += NTHREADS) barw[i] = 0u;
        __syncthreads(); }
    {
        FRESH();
        unsigned char* ws = LD_WS();
        LAS float* scr = (LAS float*)(lds + wave * 16384);
        for (int l = 0; l < NLAYER; ++l) {
            unsigned char* wl = ws + WS_W + (size_t)l * W_LAYER;
            const float* g1 = LD_IN(1) + (size_t)l * DM; const float* gm = LD_IN(5) + (size_t)l * DM; const float* g2 = LD_IN(16) + (size_t)l * DM;
            transpose_matrix(LD_IN(2) + (size_t)l * DM * DFF, DM, DFF, (bf16_t*)(wl + WO_GU1), 1, g1, scr, gw, NGW, lane);
            transpose_matrix(LD_IN(3) + (size_t)l * DM * DFF, DM, DFF, (bf16_t*)(wl + WO_GU1), 2, g1, scr, gw, NGW, lane);
            transpose_matrix(LD_IN(4) + (size_t)l * DFF * DM, DFF, DM, (bf16_t*)(wl + WO_D1), 0, nullptr, scr, gw, NGW, lane);
            transpose_matrix(LD_IN(6) + (size_t)l * DM * PW, DM, PW, (bf16_t*)(wl + WO_IN), 3, gm, scr, gw, NGW, lane);
            transpose_matrix(LD_IN(15) + (size_t)l * DM * DM, DM, DM, (bf16_t*)(wl + WO_OUT), 0, nullptr, scr, gw, NGW, lane);
            transpose_matrix(LD_IN(17) + (size_t)l * DM * DFF, DM, DFF, (bf16_t*)(wl + WO_GU2), 1, g2, scr, gw, NGW, lane);
            transpose_matrix(LD_IN(18) + (size_t)l * DM * DFF, DM, DFF, (bf16_t*)(wl + WO_GU2), 2, g2, scr, gw, NGW, lane);
            transpose_matrix(LD_IN(19) + (size_t)l * DFF * DM, DFF, DM, (bf16_t*)(wl + WO_D2), 0, nullptr, scr, gw, NGW, lane);
        }
        rope_tables((float*)(ws + WS_COS1), (float*)(ws + WS_SIN1), (float*)(ws + WS_COSX), (float*)(ws + WS_SINX), wg * NTHREADS + tid, G * NTHREADS);
        x_prep(LD_IN(0), (bf16_t*)(ws + WS_H), (float*)(ws + WS_RS), gw, NGW, lane);
    }
    grid.sync();
    const XcdBarrier xbar = xcd_barrier_post((unsigned*)(LD_WS() + 0), bst, fresh_tid(wave0));
#define GSYNC() xcd_barrier(xbar, fresh_tid(wave0))
#define GEMM_PHASE(EPI, Aoff, Woff, N_, K_, ...) do { unsigned char* ws = LD_WS(); unsigned char* wl = ws + WS_W + (size_t)l * W_LAYER; \
        pg8::Gemm g{(const bf16_t*)(ws + (Aoff)), (const bf16_t*)(wl + (Woff)), NTOK, (N_), (K_)}; pg8::StaticOrder S; S.init(NTOK, (N_), G, fresh_wave(wg)); \
        pg8::EPI E{__VA_ARGS__}; pg8::gemm_phase<pg8::EPI, pg8::StaticOrder, true, true>(lds, g, S, E, wave0); } while (0)
#define FINALIZE() do { FRESH(); unsigned char* ws = LD_WS(); finalize_rs((const float*)(ws + WS_SS), (float*)(ws + WS_RS), wg * NTHREADS + tid, G * NTHREADS); } while (0)

#pragma nounroll
    for (int l = 0; l < NLAYER; ++l) {
        const bool lastl = (l + 1 == NLAYER);
        GEMM_PHASE(EpiSwiglu, WS_H, WO_GU1, 2 * DFF, DM, (bf16_t*)(ws + WS_U), DFF, (const float*)(ws + WS_RS));
        GSYNC();
        GEMM_PHASE(EpiResid, WS_U, WO_D1, DM, DFF, (bf16_t*)(ws + WS_H), (float*)nullptr, DM, 0.5f, (float*)(ws + WS_SS), (const float*)(ws + WS_RS), -0.6931471805599453f);
        GSYNC(); FINALIZE(); GSYNC();
        GEMM_PHASE(EpiQKV, WS_H, WO_IN, PW, DM, (bf16_t*)(ws + WS_PROJ), (const float*)(ws + WS_RS), LD_IN(7) + l * 64, LD_IN(8) + l * 64, LD_IN(9) + l * 64, LD_IN(10) + l * 64, LD_IN(11) + l * 64, LD_IN(12) + l * 64,
                   (const float*)(ws + WS_COS1), (const float*)(ws + WS_SIN1), (const float*)(ws + WS_COSX), (const float*)(ws + WS_SINX), QSCALE);
        GSYNC();
        { FRESH(); unsigned char* ws = LD_WS();
          AttnArgs A{(const bf16_t*)(ws + WS_PROJ), (bf16_t*)(ws + WS_ATTA), (bf16_t*)(ws + WS_ATTB), (bf16_t*)(ws + WS_ATTC), (float*)(ws + WS_LA),
                     LD_IN(7) + l * 64, LD_IN(8) + l * 64, LD_IN(9) + l * 64, LD_IN(10) + l * 64, LD_IN(11) + l * 64, LD_IN(12) + l * 64, LD_IN(13) + l * 4};
          attn_phase(lds, A, fresh_wave(wg), G, wave, lane); }
        GSYNC();
        { FRESH(); unsigned char* ws = LD_WS();
          combine_phase((const bf16_t*)(ws + WS_ATTA), (const float*)(ws + WS_LA), (const bf16_t*)(ws + WS_ATTB), (const bf16_t*)(ws + WS_ATTC), LD_IN(14) + (size_t)l * DM, (bf16_t*)(ws + WS_CAT), gw, NGW, lane); }
        GSYNC();
        GEMM_PHASE(EpiResid, WS_CAT, WO_OUT, DM, DM, (bf16_t*)(ws + WS_H), (float*)nullptr, DM, 1.0f, (float*)(ws + WS_SS), (const float*)nullptr, 1.0f);
        GSYNC(); FINALIZE(); GSYNC();
        GEMM_PHASE(EpiSwiglu, WS_H, WO_GU2, 2 * DFF, DM, (bf16_t*)(ws + WS_U), DFF, (const float*)(ws + WS_RS));
        GSYNC();
        GEMM_PHASE(EpiResid, WS_U, WO_D2, DM, DFF, (bf16_t*)(ws + WS_H), lastl ? LD_OUT() : (float*)nullptr, DM, 0.5f, (float*)(ws + WS_SS), (const float*)(ws + WS_RS), -0.6931471805599453f);
        if (!lastl) { GSYNC(); FINALIZE(); GSYNC(); }
    }
}

extern "C" void kernel_launch(void* const* d_in, const int* in_sizes, int n_in, void* d_out, int out_size, void* d_ws, size_t ws_size, hipStream_t stream) {
    static int grid = 0;
    if (grid == 0) {
        if (n_in != 20 || out_size != NTOK * DM || ws_size < WS_END) { fprintf(stderr, "kernel_launch: unexpected shapes (n_in %d out %d ws %zu)\n", n_in, out_size, ws_size); grid = -1; return; }
        int dev = 0, cus = 0, per_cu = 0;
        hipGetDevice(&dev); hipDeviceGetAttribute(&cus, hipDeviceAttributeMultiprocessorCount, dev);
        hipFuncSetAttribute((const void*)fwd_megakernel, hipFuncAttributeMaxDynamicSharedMemorySize, LDS_BYTES);
        hipOccupancyMaxActiveBlocksPerMultiprocessor(&per_cu, (const void*)fwd_megakernel, NTHREADS, LDS_BYTES);
        if (per_cu < 1) { fprintf(stderr, "kernel_launch: occupancy query says %d blocks/CU\n", per_cu); per_cu = 1; }
        (void)hipGetLastError();
        grid = cus;
    }
    if (grid < 0) return;
    Args a{};
    for (int i = 0; i < 20; ++i) a.in[i] = (const float*)d_in[i];
    a.out = (float*)d_out; a.ws = (unsigned char*)d_ws;
    void* args[] = {&a};
    hipError_t e = hipLaunchCooperativeKernel((const void*)fwd_megakernel, dim3(grid), dim3(NTHREADS), args, LDS_BYTES, stream);
    if (e != hipSuccess) fprintf(stderr, "cooperative launch failed: %s (grid %d)\n", hipGetErrorString(e), grid);
}
```

```cpp
#include <hip/hip_runtime.h>
#include <hip/hip_cooperative_groups.h>
#include <cstdio>
#include <cstdint>
namespace cg = cooperative_groups;
__device__ __forceinline__ int lane_id_fresh() { unsigned z; asm volatile("s_mov_b32 %0, 0" : "=s"(z)); return (int)__builtin_amdgcn_mbcnt_hi(~0u, __builtin_amdgcn_mbcnt_lo(~0u, z)); }
__device__ __forceinline__ int fresh_wave(int w) { asm volatile("" : "+s"(w)); return w; }
namespace pg8 {
#define PG8_LAS __attribute__((address_space(3)))
typedef unsigned short bf16_t;
typedef short bf16x8 __attribute__((ext_vector_type(8)));
typedef float f32x4 __attribute__((ext_vector_type(4)));
typedef unsigned u32x4 __attribute__((ext_vector_type(4)));
constexpr int BM = 256, BK = 64, HALF = 128, HTB = HALF * BK * 2  , STAGE_BYTES = 8 * HTB, NXCD = 8, WGM = 8;

__host__ __device__ __forceinline__ int lds_byte(int r, int c) { const int st = (r >> 4) * 2 + (c >> 5), rr = r & 15, cc = c & 31, ob = rr * 64 + cc * 2; return st * 1024 + (ob ^ (((ob >> 9) & 1) << 5)); }
__host__ __device__ __forceinline__ void stage_rc(int b, int& R, int& C) { const int st = b / 1024, sb = b % 1024, swz = sb ^ (((sb >> 9) & 1) << 5); R = (st >> 1) * 16 + swz / 64; C = (st & 1) * 32 + (swz % 64) / 2; }
__host__ __device__ __forceinline__ int perm32(int rho) { const int n = rho >> 4, i = rho & 15; return 8 * (i >> 2) + 4 * n + (i & 3); }

struct Unit { int pm, pn; };
struct Gemm { const bf16_t* A; const bf16_t* Bt; int M, N, K; };

struct StaticOrder {
    int nM, nN, nwg, G, c;
    __host__ __device__ void init(int M, int N, int G_, int c_) { nM = M / BM; nN = N / BM; nwg = nM * nN; G = G_; c = c_; }
    __host__ __device__ bool next(int i, Unit& u) const {
        const long L = (long)i * G + c; if (L >= nwg) return false;
        int wgid = (int)L; { const int q = nwg / NXCD, r = nwg % NXCD, xcd = wgid % NXCD, off = wgid / NXCD; wgid = (xcd < r ? xcd * (q + 1) : r * (q + 1) + (xcd - r) * q) + off; }
        const int nig = WGM * nN, gid = wgid / nig, fm = gid * WGM, gsz = (nM - fm) < WGM ? (nM - fm) : WGM;
        u.pm = fm + ((wgid % nig) % gsz); u.pn = (wgid % nig) / gsz; return true;
    }
    __device__ __forceinline__ void a_ready(const Unit&) const {}
    __device__ __forceinline__ void done(const Unit&) const {}
};

__device__ __forceinline__ unsigned cvt_pk_bf16(float lo, float hi) { unsigned r; asm volatile("v_cvt_pk_bf16_f32 %0, %1, %2" : "=v"(r) : "v"(lo), "v"(hi)); return r; }
typedef float f32x2 __attribute__((ext_vector_type(2)));
__device__ __forceinline__ f32x2 gelu_pk(f32x2 v) {
    const f32x2 av = __builtin_elementwise_abs(v), d = av * 0.2316418882f + 1.0f;
    f32x2 t; t.x = __builtin_amdgcn_rcpf(d.x); t.y = __builtin_amdgcn_rcpf(d.y);
    f32x2 q = t * 0.5307027145f + (-0.7265760135f); q = q * t + 0.7107068705f; q = q * t + (-0.142248368f); q = q * t + 0.127414796f; q = q * t;
    const f32x2 s = (v * v) * (-0.72134752044f);
    f32x2 e; e.x = __builtin_amdgcn_exp2f(s.x); e.y = __builtin_amdgcn_exp2f(s.y);
    const f32x2 m = v * (q * e), r = v - m;
    f32x2 o; o.x = v.x < 0.f ? m.x : r.x; o.y = v.y < 0.f ? m.y : r.y; return o;
}

template <int ACT  > struct EpiBf16 {
    static constexpr bool PERM = true, AFTER_DRAIN = false; static_assert(ACT == 0 || ACT == 1, "EpiBf16: ACT is 0 (none) or 1 (gelu_pk)");
    bf16_t* O; int ldc; const float* bias; int split_cols; size_t split_stride; float scale0;
    __device__ __forceinline__ void operator()(const f32x4 (&acc)[2][2][4][2], const Unit& u, int wr, int wc, int fr, int fq) const {
        const int row0 = u.pm * BM + wr * 64 + fr; int colt = u.pn * BM; bf16_t* base = O;
        float sc = 1.f; if (split_cols) { const int t = colt / split_cols; base += (size_t)t * split_stride; colt -= t * split_cols; if (t == 0) sc = scale0; }
        const int col0 = colt + wc * 32 + 8 * fq, bcol0 = u.pn * BM + wc * 32 + 8 * fq;
        f32x4 bv[2][2];
#pragma unroll
        for (int bj = 0; bj < 2; ++bj)
#pragma unroll
            for (int n = 0; n < 2; ++n) bv[bj][n] = bias ? *(const f32x4*)(bias + bcol0 + bj * HALF + 4 * n) : (f32x4){0.f, 0.f, 0.f, 0.f};
#pragma unroll
        for (int ai = 0; ai < 2; ++ai)
#pragma unroll
            for (int m = 0; m < 4; ++m) { bf16_t* rowp = base + (size_t)(row0 + ai * HALF + m * 16) * ldc + col0;
#pragma unroll
                for (int bj = 0; bj < 2; ++bj) { f32x4 v0 = acc[ai][bj][m][0] + bv[bj][0], v1 = acc[ai][bj][m][1] + bv[bj][1];
                    if (ACT == 1) { f32x2 a = gelu_pk((f32x2){v0[0], v0[1]}), b = gelu_pk((f32x2){v0[2], v0[3]}), c = gelu_pk((f32x2){v1[0], v1[1]}), d = gelu_pk((f32x2){v1[2], v1[3]});
                        v0 = (f32x4){a.x, a.y, b.x, b.y}; v1 = (f32x4){c.x, c.y, d.x, d.y}; }
                    v0 = v0 * sc; v1 = v1 * sc; u32x4 w; w.x = cvt_pk_bf16(v0[0], v0[1]); w.y = cvt_pk_bf16(v0[2], v0[3]); w.z = cvt_pk_bf16(v1[0], v1[1]); w.w = cvt_pk_bf16(v1[2], v1[3]);
                    *(u32x4*)(rowp + bj * HALF) = w; } }
    }
};
typedef unsigned u32x2 __attribute__((ext_vector_type(2)));
struct EpiSwiglu {
    static constexpr bool PERM = true, AFTER_DRAIN = false;
    bf16_t* O; int ldc; const float* ss;
    __device__ __forceinline__ void operator()(const f32x4 (&acc)[2][2][4][2], const Unit& u, int wr, int wc, int fr, int fq) const {
        const int row0 = u.pm * BM + wr * 64 + fr; const int col0 = u.pn * HALF + wc * 32 + 8 * fq;
#pragma unroll
        for (int ai = 0; ai < 2; ++ai)
#pragma unroll
            for (int m = 0; m < 4; ++m) {
                const int row = row0 + ai * HALF + m * 16;
                const float rs = ss[row];
                bf16_t* rowp = O + (size_t)row * ldc + col0;
                float v[8];
#pragma unroll
                for (int n = 0; n < 2; ++n)
#pragma unroll
                    for (int i = 0; i < 4; ++i) { const float ag = acc[ai][0][m][n][i], au = acc[ai][1][m][n][i];
                        const float e = __builtin_amdgcn_exp2f(ag * rs);
                        v[n * 4 + i] = (ag * au) * __builtin_amdgcn_rcpf(1.0f + e); }
                u32x4 w; w.x = cvt_pk_bf16(v[0], v[1]); w.y = cvt_pk_bf16(v[2], v[3]); w.z = cvt_pk_bf16(v[4], v[5]); w.w = cvt_pk_bf16(v[6], v[7]);
                *(u32x4*)rowp = w;
            }
    }
};
struct EpiResid {
    static constexpr bool PERM = true, AFTER_DRAIN = false;
    bf16_t* xb; float* fout; int ldc; float scale; float* ssout; const float* rowrs; float rowk;
    __device__ __forceinline__ void operator()(const f32x4 (&acc)[2][2][4][2], const Unit& u, int wr, int wc, int fr, int fq) const {
        const int row0 = u.pm * BM + wr * 64 + fr; const int col0 = u.pn * BM + wc * 32 + 8 * fq;
#pragma unroll
        for (int ai = 0; ai < 2; ++ai) {
            u32x4 b[4][2];
#pragma unroll
            for (int m = 0; m < 4; ++m) { const size_t off = (size_t)(row0 + ai * HALF + m * 16) * ldc + col0;
#pragma unroll
                for (int bj = 0; bj < 2; ++bj) b[m][bj] = *(const u32x4*)(xb + off + bj * HALF); }
            asm volatile("" ::: "memory");
#pragma unroll
            for (int m = 0; m < 4; ++m) { const int row = row0 + ai * HALF + m * 16; const size_t off = (size_t)row * ldc + col0; float s = 0.f;
                float sc = scale; if (rowrs) { const float r_ = rowrs[row]; sc = scale * rowk * r_ * r_; }
#pragma unroll
                for (int bj = 0; bj < 2; ++bj) { const u32x4 w = b[m][bj];
                    f32x4 r0 = {__builtin_bit_cast(float, w.x << 16), __builtin_bit_cast(float, w.x & 0xffff0000u), __builtin_bit_cast(float, w.y << 16), __builtin_bit_cast(float, w.y & 0xffff0000u)};
                    f32x4 r1 = {__builtin_bit_cast(float, w.z << 16), __builtin_bit_cast(float, w.z & 0xffff0000u), __builtin_bit_cast(float, w.w << 16), __builtin_bit_cast(float, w.w & 0xffff0000u)};
                    r0 = r0 + acc[ai][bj][m][0] * sc; r1 = r1 + acc[ai][bj][m][1] * sc;
                    if (fout) { *(f32x4*)(fout + off + bj * HALF) = r0; *(f32x4*)(fout + off + bj * HALF + 4) = r1; }
                    else { s += (r0[0] * r0[0] + r0[1] * r0[1]) + (r0[2] * r0[2] + r0[3] * r0[3]) + (r1[0] * r1[0] + r1[1] * r1[1]) + (r1[2] * r1[2] + r1[3] * r1[3]);
                        u32x4 o; o.x = cvt_pk_bf16(r0[0], r0[1]); o.y = cvt_pk_bf16(r0[2], r0[3]); o.z = cvt_pk_bf16(r1[0], r1[1]); o.w = cvt_pk_bf16(r1[2], r1[3]);
                        *(u32x4*)(xb + off + bj * HALF) = o; } }
                if (!fout) { s += __shfl_xor(s, 16); s += __shfl_xor(s, 32); if (fq == 0) ssout[(size_t)row * 16 + u.pn * 4 + wc] = s; } }
            asm volatile("" ::: "memory");
        }
    }
};
struct EpiQKV {
    static constexpr bool PERM = true, AFTER_DRAIN = false;
    bf16_t* O; const float* ss; const float *aqn, *akn, *bqn, *bkn, *cqn, *ckn; const float *cos1, *sin1, *cosx, *sinx; float qscale;
    __device__ __forceinline__ void operator()(const f32x4 (&acc)[2][2][4][2], const Unit& u, int wr, int wc, int fr, int fq) const {
        const int hidx = 4 * u.pn + wc;
        int kind = 0; const float* gp = aqn; bool isq = false;
        if (hidx < 8) { kind = 1; gp = aqn; isq = true; } else if (hidx < 16) { kind = 1; gp = akn; }
        else if (hidx < 24) { kind = 0; } else if (hidx < 28) { kind = 2; gp = bqn; isq = true; } else if (hidx < 30) { kind = 2; gp = bkn; }
        else if (hidx < 32) { kind = 0; } else if (hidx < 36) { kind = 1; gp = cqn; isq = true; } else if (hidx < 38) { kind = 1; gp = ckn; }
        const int row0 = u.pm * BM + wr * 64 + fr;
        bf16_t* obase = O + hidx * 64 + 8 * fq;
        if (kind == 0) {
            float rsv[8];
#pragma unroll
            for (int g = 0; g < 8; ++g) rsv[g] = ss[row0 + (g >> 2) * HALF + (g & 3) * 16];
#pragma unroll
            for (int g = 0; g < 8; ++g) { const int ai = g >> 2, m = g & 3; const int row = row0 + ai * HALF + m * 16; const float rs = rsv[g];
#pragma unroll
                for (int bj = 0; bj < 2; ++bj) { const f32x4 x0 = acc[ai][bj][m][0] * rs, x1 = acc[ai][bj][m][1] * rs;
                    u32x4 w; w.x = cvt_pk_bf16(x0[0], x0[1]); w.y = cvt_pk_bf16(x0[2], x0[3]); w.z = cvt_pk_bf16(x1[0], x1[1]); w.w = cvt_pk_bf16(x1[2], x1[3]);
                    *(u32x4*)(obase + (size_t)row * 2560 + 32 * bj) = w; } }
            return;
        }
        f32x4 gv[2][2];
#pragma unroll
        for (int bj = 0; bj < 2; ++bj)
#pragma unroll
            for (int n = 0; n < 2; ++n) gv[bj][n] = *(const f32x4*)(gp + 32 * bj + (kind == 2 ? 16 * n + 4 * fq : 8 * fq + 4 * n));
        const float hs = isq ? qscale : 1.0f;
        f32x4 tc[1][2], ts[1][2]; float rsb[2];
        auto load_tabs = [&](int g, f32x4 (&c)[2], f32x4 (&sn)[2]) {
            const int t = (row0 + (g >> 2) * HALF + (g & 3) * 16) & 4095; rsb[g & 1] = ss[row0 + (g >> 2) * HALF + (g & 3) * 16];
            if (kind == 1) {
#pragma unroll
                for (int n = 0; n < 2; ++n) { c[n] = *(const f32x4*)(cos1 + t * 32 + 8 * fq + 4 * n); sn[n] = *(const f32x4*)(sin1 + t * 32 + 8 * fq + 4 * n); }
            } else {
#pragma unroll
                for (int bj = 0; bj < 2; ++bj) { const int pos = bj == 0 ? (t >> 6) : (t & 63); c[bj] = *(const f32x4*)(cosx + pos * 16 + 4 * fq); sn[bj] = *(const f32x4*)(sinx + pos * 16 + 4 * fq); }
            }
        };
        float ssq[8];
#pragma unroll
        for (int g = 0; g < 8; ++g) { const int ai = g >> 2, m = g & 3; float q = 0.f;
#pragma unroll
            for (int bj = 0; bj < 2; ++bj)
#pragma unroll
                for (int n = 0; n < 2; ++n) { const f32x4 a = acc[ai][bj][m][n]; q += (a[0] * a[0] + a[1] * a[1]) + (a[2] * a[2] + a[3] * a[3]); }
            ssq[g] = q; }
        load_tabs(0, tc[0], ts[0]);
#pragma unroll
        for (int g = 0; g < 8; ++g) ssq[g] += __shfl_xor(ssq[g], 16);
#pragma unroll
        for (int g = 0; g < 8; ++g) ssq[g] += __shfl_xor(ssq[g], 32);
#pragma unroll
        for (int g = 0; g < 8; ++g) {
            const int ai = g >> 2, m = g & 3;
            const int row = row0 + ai * HALF + m * 16; const float rs = rsb[g & 1];
            const float sc = rs * hs / sqrtf(rs * rs * ssq[g] * (1.0f / 64.0f) + 1e-6f);
            f32x4 x[2][2];
#pragma unroll
            for (int bj = 0; bj < 2; ++bj)
#pragma unroll
                for (int n = 0; n < 2; ++n) x[bj][n] = acc[ai][bj][m][n] * sc * gv[bj][n];
            if (kind == 1) {
#pragma unroll
                for (int n = 0; n < 2; ++n) { const f32x4 c = tc[0][n], sn = ts[0][n];
                    const f32x4 o0 = x[0][n] * c - x[1][n] * sn, o1 = x[1][n] * c + x[0][n] * sn; x[0][n] = o0; x[1][n] = o1; }
            } else {
#pragma unroll
                for (int bj = 0; bj < 2; ++bj) { const f32x4 c = tc[0][bj], sn = ts[0][bj];
                    const f32x4 o0 = x[bj][0] * c - x[bj][1] * sn, o1 = x[bj][1] * c + x[bj][0] * sn; x[bj][0] = o0; x[bj][1] = o1; }
            }
            asm volatile("" ::: "memory");
            if (g + 1 < 8) load_tabs(g + 1, tc[0], ts[0]);
            asm volatile("" ::: "memory");
#pragma unroll
            for (int bj = 0; bj < 2; ++bj) { u32x4 w; w.x = cvt_pk_bf16(x[bj][0][0], x[bj][0][1]); w.y = cvt_pk_bf16(x[bj][0][2], x[bj][0][3]);
                w.z = cvt_pk_bf16(x[bj][1][0], x[bj][1][1]); w.w = cvt_pk_bf16(x[bj][1][2], x[bj][1][3]);
                *(u32x4*)(obase + (size_t)row * 2560 + 32 * bj) = w; }
        }
    }
};
template <class Epi, class Sched, bool ALIGN_EPI = false, bool SP2 = false>
__device__ __forceinline__ void gemm_phase(PG8_LAS unsigned char* lds, const Gemm g, const Sched& S, const Epi& E, const int wave0_) {
    const int wave0 = fresh_wave(wave0_);
    const int tid = wave0 * 64 + lane_id_fresh(), wid = wave0, lane = tid & 63, wr = wid >> 2, wc = wid & 3, fr = lane & 15, fq = lane >> 4;
    const int K = g.K, nt = K / BK;
    unsigned voffA[2], voffB[2];
#pragma unroll
    for (int i = 0; i < 2; ++i) { int R, C; stage_rc(tid * 16 + i * 8192, R, C); const int Rb = Epi::PERM ? ((R & ~31) + perm32(R & 31)) : R;
        voffA[i] = (unsigned)(R * K + C) * 2u; voffB[i] = (unsigned)(Rb * K + C) * 2u; }
    const size_t kstep = (size_t)(BK * 2);
    const size_t hstep = (size_t)HALF * K * 2;
    const size_t tstep = 2 * hstep;
    const unsigned ldsw = (unsigned)wid * 1024u;
    const int aoff = lds_byte(wr * 64 + fr, fq * 8), boff = lds_byte(wc * 32 + fr, fq * 8);
#define PG8_SA(b, h) (((b) * 2 + (h)) * HTB)
#define PG8_SB(b, h) ((4 + (b) * 2 + (h)) * HTB)
#define PG8_STAGE(bufoff, gbase, voff) do { _Pragma("unroll") for (int _i = 0; _i < 2; ++_i) \
        __builtin_amdgcn_global_load_lds((const unsigned*)((const char*)(gbase) + (voff)[_i]), (PG8_LAS unsigned*)(lds + (bufoff) + ldsw + _i * 8192), 16, 0, 0); } while (0)
#define PG8_LDA(dst, b, h) do { _Pragma("unroll") for (int m = 0; m < 4; ++m) _Pragma("unroll") for (int k = 0; k < 2; ++k) dst[m][k] = *(const PG8_LAS bf16x8*)(lds + PG8_SA(b, h) + aoff + m * 2048 + k * 1024); } while (0)
#define PG8_LDB(dst, b, h) do { _Pragma("unroll") for (int n = 0; n < 2; ++n) _Pragma("unroll") for (int k = 0; k < 2; ++k) dst[n][k] = *(const PG8_LAS bf16x8*)(lds + PG8_SB(b, h) + boff + n * 2048 + k * 1024); } while (0)
#define PG8_MMA(ai, bj, At, Bt) do { __builtin_amdgcn_s_setprio(1); _Pragma("unroll") for (int m = 0; m < 4; ++m) _Pragma("unroll") for (int n = 0; n < 2; ++n) _Pragma("unroll") for (int k = 0; k < 2; ++k) \
        acc[ai][bj][m][n] = __builtin_amdgcn_mfma_f32_16x16x32_bf16(Bt[n][k], At[m][k], acc[ai][bj][m][n], 0, 0, 0); __builtin_amdgcn_s_setprio(0); } while (0)
#define PG8_WAIT_V(n) asm volatile("s_waitcnt vmcnt(" #n ")" ::: "memory")
#define PG8_WAIT_L(n) asm volatile("s_waitcnt lgkmcnt(" #n ")" ::: "memory")
#define PG8_BAR __builtin_amdgcn_s_barrier()
#define PG8_SCHED __builtin_amdgcn_sched_barrier(0)
    Unit cur, nxt; int ui = 0;
    if (!S.next(0, cur)) return;
    f32x4 acc[2][2][4][2];
#pragma unroll
    for (int a = 0; a < 2; ++a)
#pragma unroll
        for (int b = 0; b < 2; ++b)
#pragma unroll
            for (int m = 0; m < 4; ++m)
#pragma unroll
                for (int n = 0; n < 2; ++n) acc[a][b][m][n] = (f32x4){0.f, 0.f, 0.f, 0.f};
    bf16x8 At[4][2], B0[2][2], B1[2][2];
    const char* cA = (const char*)g.A + (size_t)cur.pm * tstep; const char* cB = (const char*)g.Bt + (size_t)cur.pn * tstep;
    S.a_ready(cur);
    if constexpr (SP2) {
        PG8_STAGE(PG8_SB(0, 0), cB, voffB); PG8_STAGE(PG8_SB(0, 1), cB + hstep, voffB); PG8_STAGE(PG8_SA(0, 0), cA, voffA); PG8_STAGE(PG8_SA(0, 1), cA + hstep, voffA);
        if (wr == 1) PG8_BAR;
        PG8_WAIT_V(2); PG8_BAR;
        PG8_STAGE(PG8_SB(1, 0), cB + kstep, voffB); PG8_STAGE(PG8_SA(1, 0), cA + kstep, voffA); PG8_STAGE(PG8_SB(1, 1), cB + hstep + kstep, voffB);
        PG8_WAIT_V(6); PG8_BAR;
    } else {
        PG8_STAGE(PG8_SB(0, 0), cB, voffB); PG8_STAGE(PG8_SA(0, 0), cA, voffA); PG8_STAGE(PG8_SB(0, 1), cB + hstep, voffB); PG8_STAGE(PG8_SA(0, 1), cA + hstep, voffA);
        if (wr == 1) PG8_BAR;
        PG8_WAIT_V(4); PG8_BAR;
        PG8_STAGE(PG8_SB(1, 0), cB + kstep, voffB); PG8_STAGE(PG8_SA(1, 0), cA + kstep, voffA); PG8_STAGE(PG8_SB(1, 1), cB + hstep + kstep, voffB);
        PG8_WAIT_V(6); PG8_BAR;
    }
    for (;;) {
        const bool has_next = S.next(ui + 1, nxt);
        const char* nA = has_next ? (const char*)g.A + (size_t)nxt.pm * tstep : cA; const char* nB = has_next ? (const char*)g.Bt + (size_t)nxt.pn * tstep : cB;
        for (int t = 0; t < nt; t += 2) {
            const bool last = (t == nt - 2);
            const char* a1 = cA + (size_t)(t + 1) * kstep;
            const char* a2 = last ? nA : cA + (size_t)(t + 2) * kstep; const char* b2 = last ? nB : cB + (size_t)(t + 2) * kstep;
            const char* a3 = a2 + kstep; const char* b3 = b2 + kstep;
            if (last && has_next) S.a_ready(nxt);
            if constexpr (SP2) {
            PG8_LDB(B0, 0, 0); PG8_LDB(B1, 0, 1); PG8_SCHED; PG8_LDA(At, 0, 0); PG8_STAGE(PG8_SA(1, 1), a1 + hstep, voffA);
            PG8_WAIT_V(8); PG8_WAIT_L(0); PG8_BAR; PG8_MMA(0, 0, At, B0); PG8_MMA(0, 1, At, B1); PG8_BAR; PG8_SCHED;
            PG8_LDA(At, 0, 1); PG8_STAGE(PG8_SB(0, 0), b2, voffB); PG8_STAGE(PG8_SB(0, 1), b2 + hstep, voffB); PG8_STAGE(PG8_SA(0, 0), a2, voffA);
            PG8_WAIT_V(8); PG8_WAIT_L(0); PG8_BAR; PG8_MMA(1, 0, At, B0); PG8_MMA(1, 1, At, B1); PG8_BAR; PG8_SCHED;
            PG8_LDB(B0, 1, 0); PG8_LDB(B1, 1, 1); PG8_SCHED; PG8_LDA(At, 1, 0); PG8_STAGE(PG8_SA(0, 1), a2 + hstep, voffA);
            PG8_WAIT_V(8); PG8_WAIT_L(0); PG8_BAR; PG8_MMA(0, 0, At, B0); PG8_MMA(0, 1, At, B1); PG8_BAR; PG8_SCHED;
            PG8_LDA(At, 1, 1); PG8_STAGE(PG8_SB(1, 0), b3, voffB); PG8_STAGE(PG8_SB(1, 1), b3 + hstep, voffB); PG8_STAGE(PG8_SA(1, 0), a3, voffA);
            PG8_WAIT_V(8); PG8_WAIT_L(0); PG8_BAR; PG8_MMA(1, 0, At, B0); PG8_MMA(1, 1, At, B1); PG8_BAR; PG8_SCHED;
            } else {
            PG8_LDB(B0, 0, 0); PG8_SCHED; PG8_LDA(At, 0, 0); PG8_STAGE(PG8_SA(1, 1), a1 + hstep, voffA);
            PG8_WAIT_L(8); PG8_BAR; PG8_WAIT_L(0); PG8_MMA(0, 0, At, B0); PG8_BAR; PG8_SCHED;
            PG8_LDB(B1, 0, 1); PG8_STAGE(PG8_SB(0, 0), b2, voffB);
            PG8_BAR; PG8_WAIT_L(0); PG8_MMA(0, 1, At, B1); PG8_BAR;
            PG8_LDA(At, 0, 1); PG8_STAGE(PG8_SA(0, 0), a2, voffA);
            PG8_BAR; PG8_WAIT_L(0); PG8_MMA(1, 0, At, B0); PG8_BAR; PG8_SCHED;
            PG8_STAGE(PG8_SB(0, 1), b2 + hstep, voffB);
            PG8_WAIT_V(6); PG8_BAR; PG8_MMA(1, 1, At, B1); PG8_BAR;
            PG8_LDB(B0, 1, 0); PG8_SCHED; PG8_LDA(At, 1, 0); PG8_STAGE(PG8_SA(0, 1), a2 + hstep, voffA);
            PG8_WAIT_L(8); PG8_BAR; PG8_WAIT_L(0); PG8_MMA(0, 0, At, B0); PG8_BAR; PG8_SCHED;
            PG8_LDB(B1, 1, 1); PG8_STAGE(PG8_SB(1, 0), b3, voffB);
            PG8_BAR; PG8_WAIT_L(0); PG8_MMA(0, 1, At, B1); PG8_BAR;
            PG8_LDA(At, 1, 1); PG8_STAGE(PG8_SA(1, 0), a3, voffA);
            PG8_BAR; PG8_WAIT_L(0); PG8_MMA(1, 0, At, B0); PG8_BAR; PG8_SCHED;
            PG8_STAGE(PG8_SB(1, 1), b3 + hstep, voffB);
            PG8_WAIT_V(6); PG8_BAR; PG8_MMA(1, 1, At, B1); PG8_BAR;
            }
        }
        if constexpr (ALIGN_EPI) { if (wr == 0) PG8_BAR; }
        if constexpr (!Epi::AFTER_DRAIN) { E(acc, cur, wr, wc, fr, fq); S.done(cur); }
        if (!has_next) break;
#pragma unroll
        for (int a = 0; a < 2; ++a)
#pragma unroll
            for (int b = 0; b < 2; ++b)
#pragma unroll
                for (int m = 0; m < 4; ++m)
#pragma unroll
                    for (int n = 0; n < 2; ++n) acc[a][b][m][n] = (f32x4){0.f, 0.f, 0.f, 0.f};
        cur = nxt; cA = nA; cB = nB; ++ui;
        if constexpr (ALIGN_EPI) { if (wr == 1) PG8_BAR; }
    }
    PG8_WAIT_V(0);
    if constexpr (!ALIGN_EPI) { if (wr == 0) PG8_BAR; }
    PG8_BAR;
    if constexpr (Epi::AFTER_DRAIN) { E.fused(acc, cur, wr, wc, fr, fq, lds, wid, lane); S.done(cur); }
#undef PG8_SA
#undef PG8_SB
#undef PG8_STAGE
#undef PG8_LDA
#undef PG8_LDB
#undef PG8_MMA
#undef PG8_WAIT_V
#undef PG8_WAIT_L
#undef PG8_BAR
#undef PG8_SCHED
}
}
typedef unsigned short bf16_t;
typedef short bf16x8 __attribute__((ext_vector_type(8)));
typedef short s16x4 __attribute__((ext_vector_type(4)));
typedef float f32x4 __attribute__((ext_vector_type(4)));
typedef float f32x16 __attribute__((ext_vector_type(16)));
typedef unsigned u32x4 __attribute__((ext_vector_type(4)));
typedef unsigned u32x2 __attribute__((ext_vector_type(2)));
#define LAS __attribute__((address_space(3)))
constexpr int NTOK = 32768, DM = 1024, DFF = 2816, PW = 2560, SEQ = 4096, NBATCH = 8, NLAYER = 2;
constexpr int AQ = 0, AK = 512, AV = 1024, BQ = 1536, BK = 1792, BV = 1920, CQ = 2048, CK = 2304, CV = 2432;
constexpr float EPS = 1e-6f;
constexpr float QSCALE = 0.125f * 1.4426950408889634f;
constexpr int NWAVES = 8, NTHREADS = 512;
constexpr int LDS_BYTES = 147456;
constexpr size_t MiB = 1u << 20;
constexpr size_t WS_COS1 = 1 * MiB, WS_SIN1 = WS_COS1 + 512 * 1024, WS_COSX = 2 * MiB, WS_SINX = WS_COSX + 4096;
constexpr size_t WS_W = 4 * MiB, W_LAYER = 40 * MiB;
constexpr size_t WO_GU1 = 0, WO_D1 = 11 * MiB, WO_IN = WO_D1 + 5 * MiB + 512 * 1024, WO_OUT = WO_IN + 5 * MiB, WO_GU2 = WO_OUT + 2 * MiB, WO_D2 = WO_GU2 + 11 * MiB;
static_assert(WO_D2 + 5 * MiB + 512 * 1024 == W_LAYER, "weights per layer");
constexpr size_t WS_H = 84 * MiB, WS_U = 148 * MiB, WS_PROJ = WS_U, WS_ATTA = 324 * MiB, WS_ATTB = 420 * MiB, WS_ATTC = 436 * MiB, WS_LA = 452 * MiB, WS_END = 468 * MiB;
constexpr size_t WS_SS = 456 * MiB;
constexpr size_t WS_RS = 3 * MiB;
constexpr size_t WS_CAT = WS_PROJ;

__device__ __forceinline__ unsigned f2bf(float f) { unsigned u = __builtin_bit_cast(unsigned, f); return (u + 0x7fffu + ((u >> 16) & 1u)) >> 16; }
__device__ __forceinline__ unsigned pk2(float lo, float hi) { return f2bf(lo) | (f2bf(hi) << 16); }
__device__ __forceinline__ float bf2f(unsigned short b) { return __builtin_bit_cast(float, (unsigned)b << 16); }
__device__ __forceinline__ float bflo(unsigned w) { return __builtin_bit_cast(float, w << 16); }
__device__ __forceinline__ float bfhi(unsigned w) { return __builtin_bit_cast(float, w & 0xffff0000u); }
__device__ __forceinline__ float wave_sum(float v) {
#pragma unroll
    for (int o = 1; o < 64; o <<= 1) v += __shfl_xor(v, o);
    return v;
}
__device__ __forceinline__ float wave_max(float v) {
#pragma unroll
    for (int o = 1; o < 64; o <<= 1) v = fmaxf(v, __shfl_xor(v, o));
    return v;
}

__device__ __forceinline__ int fresh_tid(int wave0) { return wave0 * 64 + lane_id_fresh(); }
__device__ __forceinline__ int pax(int e) { return 8 * ((e & 15) >> 2) + 4 * (e >> 4) + (e & 3); }
__device__ __forceinline__ void transpose_item(const float* W, int K, int N, bf16_t* WT, int rbase, bool axial, const float* gk, LAS float* scr, int kb, int nb, int lane, float wsc = 1.0f) {
    const int k0 = 64 * kb, n0 = 32 * nb;
#pragma unroll 8
    for (int i = 0; i < 32; ++i) { const int kk = 2 * i + (lane >> 5); scr[kk * 33 + (lane & 31)] = W[(size_t)(k0 + kk) * N + n0 + (lane & 31)]; }
    asm volatile("s_waitcnt lgkmcnt(0)" ::: "memory");
    const int c = lane & 7;
    f32x4 g0 = {1.f, 1.f, 1.f, 1.f}, g1 = g0;
    if (gk) { g0 = *(const f32x4*)(gk + k0 + 8 * c) * wsc; g1 = *(const f32x4*)(gk + k0 + 8 * c + 4) * wsc; }
#pragma unroll
    for (int j = 0; j < 4; ++j) { const int n = (lane >> 3) + 8 * j; const LAS float* s = scr + (8 * c) * 33 + n;
        u32x4 o; o.x = pk2(s[0 * 33] * g0.x, s[1 * 33] * g0.y); o.y = pk2(s[2 * 33] * g0.z, s[3 * 33] * g0.w); o.z = pk2(s[4 * 33] * g1.x, s[5 * 33] * g1.y); o.w = pk2(s[6 * 33] * g1.z, s[7 * 33] * g1.w);
        const int r = rbase + (axial ? pax(n) : n);
        *(u32x4*)(WT + (size_t)r * K + k0 + 8 * c) = o; }
    asm volatile("s_waitcnt lgkmcnt(0)" ::: "memory");
}
__device__ __forceinline__ void transpose_matrix(const float* W, int K, int N, bf16_t* WT, int mode, const float* gk, LAS float* scr, int gw, int NGW, int lane) {
    const int nblk = N / 32, nitems = (K / 64) * nblk;
    for (int it = gw; it < nitems; it += NGW) {
        const int kb = it / nblk, nb = it % nblk; const int n0 = nb * 32;
        int rbase = n0; bool axial = false;
        if (mode == 1 || mode == 2) rbase = n0 + (n0 >> 7) * 128 + (mode == 2 ? 128 : 0);
        else if (mode == 3) { const int h = n0 >> 6, half = (n0 >> 5) & 1; rbase = 256 * (h >> 2) + 128 * half + 32 * (h & 3); axial = (h >= 24 && h < 30); }
        transpose_item(W, K, N, WT, rbase, axial, gk, scr, kb, nb, lane, mode == 1 ? -1.4426950408889634f : 1.0f);
    }
}
__device__ __forceinline__ void x_prep(const float* x, bf16_t* XB, float* ss, int gw, int NGW, int lane) {
    for (int m = gw; m < NTOK; m += NGW) {
        const f32x4* xr = (const f32x4*)(x + (size_t)m * DM) + lane; f32x4 v[4]; float s = 0.f;
#pragma unroll
        for (int j = 0; j < 4; ++j) { v[j] = xr[64 * j]; s += (v[j].x * v[j].x + v[j].y * v[j].y) + (v[j].z * v[j].z + v[j].w * v[j].w); }
        s = wave_sum(s);
        u32x2* o = (u32x2*)(XB + (size_t)m * DM) + lane;
#pragma unroll
        for (int j = 0; j < 4; ++j) { u32x2 w; w.x = pk2(v[j].x, v[j].y); w.y = pk2(v[j].z, v[j].w); o[64 * j] = w; }
        if (lane == 0) ss[m] = 1.0f / sqrtf(s * (1.0f / DM) + EPS);
    }
}
__device__ __forceinline__ void sincos_rev(float ang, float& c, float& s) {
    double r = (double)ang * 0.15915494309189533577; r -= __builtin_rint(r);
    const float rf = (float)r; s = __builtin_amdgcn_sinf(rf); c = __builtin_amdgcn_cosf(rf);
}
__device__ __forceinline__ void rope_tables(float* cos1, float* sin1, float* cosx, float* sinx, int gtid, int NGT) {
    for (int i = gtid; i < SEQ * 32; i += NGT) { const int t = i >> 5, j = i & 31;
        const float inv = 1.0f / __builtin_powf(10000.0f, (float)(2 * j) / 64.0f); const float ang = (float)t * inv; float c, s; sincos_rev(ang, c, s); cos1[i] = c; sin1[i] = s; }
    for (int i = gtid; i < 64 * 16; i += NGT) { const int p = i >> 4, j = i & 15;
        const float inv = 1.0f / __builtin_powf(10000.0f, (float)(2 * j) / 32.0f); const float ang = (float)p * inv; float c, s; sincos_rev(ang, c, s); cosx[i] = c; sinx[i] = s; }
}

__device__ __forceinline__ unsigned cvtpk(float lo, float hi) { typedef float f2 __attribute__((ext_vector_type(2))); typedef __bf16 b2 __attribute__((ext_vector_type(2)));
    f2 v = {lo, hi}; b2 b = __builtin_convertvector(v, b2); return __builtin_bit_cast(unsigned, b); }
typedef short v4i16_t __attribute__((ext_vector_type(4)));
__device__ __forceinline__ s16x4 vtr(LAS const unsigned char* p) { return __builtin_bit_cast(s16x4, __builtin_amdgcn_ds_read_tr16_b64_v4i16((LAS v4i16_t*)p)); }
__device__ __forceinline__ int crow(int r, int hi) { return (r & 3) + 8 * (r >> 2) + 4 * hi; }

#define SBAR() __builtin_amdgcn_sched_barrier(0)
__device__ __forceinline__ void k_load(LAS const unsigned char* kb, int r32, int hi, bf16x8 (&kf)[8]) {
#pragma unroll
    for (int d0 = 0; d0 < 4; ++d0) { const int c = 2 * d0 + hi;
        kf[2 * d0] = *(LAS const bf16x8*)(kb + c * 1024 + ((r32 ^ c) * 16));
        kf[2 * d0 + 1] = *(LAS const bf16x8*)(kb + c * 1024 + 512 + ((r32 ^ c) * 16)); }
}
__device__ __forceinline__ void qk_mma(const bf16x8 (&kf)[8], const bf16x8 (&qf)[4], f32x16& s0, f32x16& s1) {
    const f32x16 z = {0.f, 0.f, 0.f, 0.f, 0.f, 0.f, 0.f, 0.f, 0.f, 0.f, 0.f, 0.f, 0.f, 0.f, 0.f, 0.f};
    s0 = __builtin_amdgcn_mfma_f32_32x32x16_bf16(kf[0], qf[0], z, 0, 0, 0); s1 = __builtin_amdgcn_mfma_f32_32x32x16_bf16(kf[1], qf[0], z, 0, 0, 0);
#pragma unroll
    for (int d0 = 1; d0 < 4; ++d0) { s0 = __builtin_amdgcn_mfma_f32_32x32x16_bf16(kf[2 * d0], qf[d0], s0, 0, 0, 0); s1 = __builtin_amdgcn_mfma_f32_32x32x16_bf16(kf[2 * d0 + 1], qf[d0], s1, 0, 0, 0); }
}
__device__ __forceinline__ void v_load(LAS const unsigned char* vb, s16x4 (&vf)[16]) {
#pragma unroll
    for (int s = 0; s < 4; ++s)
#pragma unroll
        for (int d0 = 0; d0 < 2; ++d0) { vf[4 * s + 2 * d0] = vtr(vb + d0 * 4096 + s * 1024); vf[4 * s + 2 * d0 + 1] = vtr(vb + d0 * 4096 + s * 1024 + 512); }
}
__device__ __forceinline__ void pv_mma(const s16x4 (&vf)[16], const u32x4 (&pw)[4], f32x16 (&o)[2]) {
#pragma unroll
    for (int s = 0; s < 4; ++s)
#pragma unroll
        for (int d0 = 0; d0 < 2; ++d0) { const s16x4 lo = vf[4 * s + 2 * d0], hh = vf[4 * s + 2 * d0 + 1];
            const bf16x8 v = (bf16x8){lo[0], lo[1], lo[2], lo[3], hh[0], hh[1], hh[2], hh[3]};
            o[d0] = __builtin_amdgcn_mfma_f32_32x32x16_bf16(v, __builtin_bit_cast(bf16x8, pw[s]), o[d0], 0, 0, 0); }
}
template <bool BAND, bool SHIFT>
__device__ __forceinline__ void softmax_tile(f32x16& s0, f32x16& s1, bool full, int base, int radius, float negshift, float& lsum, u32x4 (&pw)[4]) {
    if (SHIFT) {
#pragma unroll
        for (int r = 0; r < 16; ++r) { s0[r] += negshift; s1[r] += negshift; } }
#pragma unroll
    for (int r = 0; r < 16; ++r) { s0[r] = __builtin_amdgcn_exp2f(s0[r]); s1[r] = __builtin_amdgcn_exp2f(s1[r]); }
    if (BAND) { if (!full) {
#pragma unroll
        for (int r = 0; r < 16; ++r) { const int d = base + (r & 3) + 8 * (r >> 2); const int d1 = d + 32;
            if (d > radius || d < -radius) s0[r] = 0.f;
            if (d1 > radius || d1 < -radius) s1[r] = 0.f; } } }
    {   float t[8];
#pragma unroll
        for (int i = 0; i < 8; ++i) t[i] = (s0[i] + s0[i + 8]) + (s1[i] + s1[i + 8]);
        lsum += ((t[0] + t[1]) + (t[2] + t[3])) + ((t[4] + t[5]) + (t[6] + t[7])); }
#pragma unroll
    for (int s = 0; s < 2; ++s) {
        pw[s] = (u32x4){cvtpk(s0[8 * s + 0], s0[8 * s + 1]), cvtpk(s0[8 * s + 2], s0[8 * s + 3]), cvtpk(s0[8 * s + 4], s0[8 * s + 5]), cvtpk(s0[8 * s + 6], s0[8 * s + 7])};
        pw[2 + s] = (u32x4){cvtpk(s1[8 * s + 0], s1[8 * s + 1]), cvtpk(s1[8 * s + 2], s1[8 * s + 3]), cvtpk(s1[8 * s + 4], s1[8 * s + 5]), cvtpk(s1[8 * s + 6], s1[8 * s + 7])};
    }
}
template <bool BAND, bool SHIFT>
__device__ __forceinline__ void attn_core(LAS unsigned char* lds, const bf16_t* Kp, const bf16_t* Vp, size_t kvstride, const bf16_t* Qp, size_t qstride,
                                          int qslot0, int t_lo, int t_hi, int radius, float negshift, f32x16 (&o)[2], float& lsum, const int wave0) {
    const int tid = fresh_tid(wave0), lane = tid & 63, r32 = lane & 31, hi = lane >> 5;
    const int srow = tid >> 3, sch = tid & 7;
    bf16x8 qf[4];
#pragma unroll
    for (int d0 = 0; d0 < 4; ++d0) qf[d0] = *(const bf16x8*)(Qp + (size_t)r32 * qstride + d0 * 16 + hi * 8);
#pragma unroll
    for (int r = 0; r < 16; ++r) { o[0][r] = 0.f; o[1][r] = 0.f; }
    lsum = 0.f;
    const unsigned kw = (unsigned)(sch * 1024 + ((srow ^ sch) * 16));
    const unsigned vw = (unsigned)(16384 + (sch >> 2) * 4096 + (srow >> 4) * 1024 + (srow & 15) * 64 + (sch & 3) * 16);
    const unsigned voff = (unsigned)(((lane >> 4) & 1) * 32 + (lane & 3) * 8 + (4 * hi + ((lane & 15) >> 2)) * 64);
    const bf16_t* kg = Kp + (size_t)srow * kvstride + sch * 8;
    const bf16_t* vg = Vp + (size_t)srow * kvstride + sch * 8;
    const int tlast = t_hi - 1;
    const int n_it = (t_hi - t_lo + 1) >> 1;
    u32x4 kr0, vr0, kr1, vr1;
    { const size_t o0 = (size_t)(t_lo * 64) * kvstride; const int tb = (t_lo + 1 < t_hi) ? t_lo + 1 : tlast; const size_t o1 = (size_t)(tb * 64) * kvstride;
      kr0 = *(const u32x4*)(kg + o0); vr0 = *(const u32x4*)(vg + o0); kr1 = *(const u32x4*)(kg + o1); vr1 = *(const u32x4*)(vg + o1); }
    *(LAS u32x4*)(lds + kw) = kr0; *(LAS u32x4*)(lds + 8192 + kw) = kr1; *(LAS u32x4*)(lds + vw) = vr0; *(LAS u32x4*)(lds + 8192 + vw) = vr1;
    __syncthreads();
    for (int it = 0; it < n_it; ++it) {
        const unsigned bo = (unsigned)((it & 1) * 32768);
        const bool more = (it + 1 < n_it);
        const int tA = t_lo + 2 * it, tB = tA + 1;
        if (more) { const int ta = tA + 2; const int tb = (ta + 1 < t_hi) ? ta + 1 : tlast; const size_t o0 = (size_t)(ta * 64) * kvstride, o1 = (size_t)(tb * 64) * kvstride;
            kr0 = *(const u32x4*)(kg + o0); vr0 = *(const u32x4*)(vg + o0); kr1 = *(const u32x4*)(kg + o1); vr1 = *(const u32x4*)(vg + o1); }
        bool actA = true, actB = (tB < t_hi), fullA = true, fullB = true;
        const int kvA = tA * 64, kvB = tB * 64;
        if (BAND) {
            actA = !(kvA > qslot0 + 31 + radius || kvA + 63 < qslot0 - radius);
            actB = actB && !(kvB > qslot0 + 31 + radius || kvB + 63 < qslot0 - radius);
            fullA = (kvA >= qslot0 + 31 - radius) && (kvA + 63 <= qslot0 + radius);
            fullB = (kvB >= qslot0 + 31 - radius) && (kvB + 63 <= qslot0 + radius);
        }
        LAS const unsigned char* kbA = lds + bo; LAS const unsigned char* kbB = lds + bo + 8192;
        LAS const unsigned char* vbA = lds + bo + 16384 + voff; LAS const unsigned char* vbB = lds + bo + 24576 + voff;
        const int baseA = kvA + 4 * hi - (qslot0 + r32), baseB = baseA + 64;
        if (!BAND) {
            f32x16 a0, a1, b0, b1; u32x4 pa[4], pb[4]; s16x4 vfa[16], vfb[16]; bf16x8 kfa[8], kfb[8];
            k_load(kbA, r32, hi, kfa); SBAR();
            qk_mma(kfa, qf, a0, a1); v_load(vbA, vfa); k_load(kbB, r32, hi, kfb); SBAR();
            qk_mma(kfb, qf, b0, b1);
            softmax_tile<BAND, SHIFT>(a0, a1, true, 0, 0, negshift, lsum, pa);
#pragma unroll
            for (int i = 0; i < 8; ++i) { __builtin_amdgcn_sched_group_barrier(0x008, 1, 0); __builtin_amdgcn_sched_group_barrier(0x402, 9, 0); }
            SBAR();
            if (more) { const unsigned nb = bo ^ 32768u; *(LAS u32x4*)(lds + nb + kw) = kr0; *(LAS u32x4*)(lds + nb + 8192 + kw) = kr1; *(LAS u32x4*)(lds + nb + vw) = vr0; *(LAS u32x4*)(lds + nb + 8192 + vw) = vr1; }
            v_load(vbB, vfb); SBAR();
            pv_mma(vfa, pa, o);
            softmax_tile<BAND, SHIFT>(b0, b1, true, 0, 0, negshift, lsum, pb);
#pragma unroll
            for (int i = 0; i < 8; ++i) { __builtin_amdgcn_sched_group_barrier(0x008, 1, 0); __builtin_amdgcn_sched_group_barrier(0x402, 9, 0); }
            SBAR();
            pv_mma(vfb, pb, o); SBAR();
        } else {
#pragma unroll 1
            for (int h = 0; h < 2; ++h) {
                const bool act = h ? actB : actA;
                if (act) {
                    f32x16 a0, a1; u32x4 pa[4]; s16x4 vf[16]; bf16x8 kf[8];
                    LAS const unsigned char* kb1 = h ? kbB : kbA; LAS const unsigned char* vb1 = h ? vbB : vbA;
                    k_load(kb1, r32, hi, kf); SBAR(); qk_mma(kf, qf, a0, a1); SBAR();
                    v_load(vb1, vf); SBAR();
                    softmax_tile<BAND, SHIFT>(a0, a1, h ? fullB : fullA, h ? baseB : baseA, radius, negshift, lsum, pa);
                    SBAR(); pv_mma(vf, pa, o); SBAR();
                }
            }
        }
        if (BAND && more) { const unsigned nb = bo ^ 32768u; *(LAS u32x4*)(lds + nb + kw) = kr0; *(LAS u32x4*)(lds + nb + 8192 + kw) = kr1; *(LAS u32x4*)(lds + nb + vw) = vr0; *(LAS u32x4*)(lds + nb + 8192 + vw) = vr1; }
        __syncthreads();
    }
}
__device__ __forceinline__ void store_o(LAS unsigned char* stg, bf16_t* orow0, size_t ostride, const f32x16 (&o)[2], float sc, int lane) {
    const int r32 = lane & 31, hi = lane >> 5;
#pragma unroll
    for (int d0 = 0; d0 < 2; ++d0)
#pragma unroll
        for (int g = 0; g < 4; ++g) { u32x2 w; w.x = cvtpk(o[d0][4 * g] * sc, o[d0][4 * g + 1] * sc); w.y = cvtpk(o[d0][4 * g + 2] * sc, o[d0][4 * g + 3] * sc);
            const int ch = 4 * d0 + g; *(LAS u32x2*)(stg + r32 * 128 + ((ch ^ (r32 & 7)) * 16) + hi * 8) = w; }
#pragma unroll
    for (int p = 0; p < 4; ++p) { const int row = 8 * p + (lane >> 3), ci = lane & 7;
        const u32x4 v = *(LAS const u32x4*)(stg + row * 128 + ((ci ^ (row & 7)) * 16));
        *(u32x4*)(orow0 + (size_t)row * ostride + ci * 8) = v; }
}
struct BandUnit { const bf16_t* Kp; const bf16_t* Vp; const bf16_t* Qp; size_t stride; bf16_t* orow0; float* lrow0; int ostride, lstride; int qslot0, t_lo, t_hi, radius; float negshift, lextra, isC; };
__device__ __forceinline__ void band_issue(const BandUnit& u, int srow, int sch, u32x4 (&st)[12], bf16x8 (&qf)[4], int r32, int hi) {
#pragma unroll
    for (int j = 0; j < 6; ++j) { int t = u.t_lo + j; if (t > u.t_hi - 1) t = u.t_hi - 1;
        const size_t off = (size_t)(t * 64 + srow) * u.stride + sch * 8;
        st[2 * j] = *(const u32x4*)(u.Kp + off); st[2 * j + 1] = *(const u32x4*)(u.Vp + off); }
#pragma unroll
    for (int d0 = 0; d0 < 4; ++d0) qf[d0] = *(const bf16x8*)(u.Qp + (size_t)r32 * u.stride + d0 * 16 + hi * 8);
}
__device__ __forceinline__ void band_compute(LAS unsigned char* lds, const BandUnit& u, const bf16x8 (&qf)[4], int r32, int hi, unsigned voff, f32x16 (&o)[2], float& lsum) {
#pragma unroll
    for (int r = 0; r < 16; ++r) { o[0][r] = 0.f; o[1][r] = 0.f; }
    lsum = 0.f;
#pragma unroll 1
    for (int jh = 0; jh < 12; ++jh) {
        const int t = u.t_lo + (jh >> 1), hh = jh & 1; const int kv0 = t * 64 + 32 * hh;
        const bool act = (t < u.t_hi) && !(kv0 > u.qslot0 + 31 + u.radius || kv0 + 31 < u.qslot0 - u.radius);
        if (act) {
            const bool full = (kv0 >= u.qslot0 + 31 - u.radius) && (kv0 + 31 <= u.qslot0 + u.radius);
            const int base = kv0 + 4 * hi - (u.qslot0 + r32);
            LAS const unsigned char* kb = lds + (jh >> 1) * 16384 + hh * 512; LAS const unsigned char* vb = lds + (jh >> 1) * 16384 + 8192 + voff + hh * 2048;
            bf16x8 kf[4]; s16x4 vf[8]; f32x16 sa;
#pragma unroll
            for (int d0 = 0; d0 < 4; ++d0) { const int c = 2 * d0 + hi; kf[d0] = *(LAS const bf16x8*)(kb + c * 1024 + ((r32 ^ c) * 16)); }
            SBAR();
            { const f32x16 z = {0.f, 0.f, 0.f, 0.f, 0.f, 0.f, 0.f, 0.f, 0.f, 0.f, 0.f, 0.f, 0.f, 0.f, 0.f, 0.f};
              sa = __builtin_amdgcn_mfma_f32_32x32x16_bf16(kf[0], qf[0], z, 0, 0, 0);
#pragma unroll
              for (int d0 = 1; d0 < 4; ++d0) sa = __builtin_amdgcn_mfma_f32_32x32x16_bf16(kf[d0], qf[d0], sa, 0, 0, 0); }
            SBAR();
#pragma unroll
            for (int s = 0; s < 2; ++s)
#pragma unroll
                for (int d0 = 0; d0 < 2; ++d0) { vf[4 * s + 2 * d0] = vtr(vb + d0 * 4096 + s * 1024); vf[4 * s + 2 * d0 + 1] = vtr(vb + d0 * 4096 + s * 1024 + 512); }
            SBAR();
            if (u.negshift != 0.f) {
#pragma unroll
                for (int r = 0; r < 16; ++r) sa[r] += u.negshift; }
#pragma unroll
            for (int r = 0; r < 16; ++r) sa[r] = __builtin_amdgcn_exp2f(sa[r]);
            if (!full) {
                if (kv0 + 31 > u.qslot0 + u.radius) { const int thr = u.radius - base;
#pragma unroll
                    for (int r = 0; r < 16; ++r) { if ((r & 3) + 8 * (r >> 2) > thr) sa[r] = 0.f; } }
                else { const int thr = -u.radius - base;
#pragma unroll
                    for (int r = 0; r < 16; ++r) { if ((r & 3) + 8 * (r >> 2) < thr) sa[r] = 0.f; } } }
            lsum += (((sa[0] + sa[8]) + (sa[1] + sa[9])) + ((sa[2] + sa[10]) + (sa[3] + sa[11]))) + (((sa[4] + sa[12]) + (sa[5] + sa[13])) + ((sa[6] + sa[14]) + (sa[7] + sa[15])));
            u32x4 pw[2];
#pragma unroll
            for (int s = 0; s < 2; ++s) pw[s] = (u32x4){cvtpk(sa[8 * s + 0], sa[8 * s + 1]), cvtpk(sa[8 * s + 2], sa[8 * s + 3]), cvtpk(sa[8 * s + 4], sa[8 * s + 5]), cvtpk(sa[8 * s + 6], sa[8 * s + 7])};
            SBAR();
#pragma unroll
            for (int s = 0; s < 2; ++s)
#pragma unroll
                for (int d0 = 0; d0 < 2; ++d0) { const s16x4 lo = vf[4 * s + 2 * d0], hh2 = vf[4 * s + 2 * d0 + 1];
                    const bf16x8 v = (bf16x8){lo[0], lo[1], lo[2], lo[3], hh2[0], hh2[1], hh2[2], hh2[3]};
                    o[d0] = __builtin_amdgcn_mfma_f32_32x32x16_bf16(v, __builtin_bit_cast(bf16x8, pw[s]), o[d0], 0, 0, 0); }
            SBAR();
        }
    }
}
struct AttnArgs { const bf16_t* P; bf16_t* OA; bf16_t* OB; bf16_t* OC; float* LA; const float *aqn, *akn, *bqn, *bkn, *cqn, *ckn, *sink; };
__device__ __forceinline__ BandUnit band_decode(const AttnArgs& A, int idx, int wave, float shA, float shC0) {
    const float L2E = 1.4426950408889634f;
    BandUnit u;
    if (idx < 1024) {
        const int j0 = idx & 511; const int cc = j0 & 255, pass = j0 >> 8;
        const int pair = (cc & 7) + 8 * pass; const int batch = pair >> 1, g = pair & 1, qb = cc >> 3;
        const int r = wave >> 2, sub = wave & 3, qh = 2 * g + r;
        u.qslot0 = qb * 128 + sub * 32;
        const bf16_t* base = A.P + (size_t)batch * SEQ * PW;
        u.Qp = base + (size_t)u.qslot0 * PW + CQ + qh * 64; u.Kp = base + CK + g * 64; u.Vp = base + CV + g * 64; u.stride = PW;
        const float sk = A.sink[qh] * L2E; const float sh = (sk > 64.f || shC0 != 0.f) ? fmaxf(shC0, sk) : 0.f;
        u.negshift = -sh; u.lextra = __builtin_amdgcn_exp2f(sk - sh); u.isC = 1.f; u.radius = 128;
        int t_lo = 2 * qb - 2, t_hi = 2 * qb + 4; if (t_lo < 0) t_lo = 0; if (t_hi > 64) t_hi = 64; u.t_lo = t_lo; u.t_hi = t_hi;
        u.orow0 = A.OC + ((size_t)batch * SEQ + u.qslot0) * 256 + qh * 64; u.lrow0 = nullptr; u.ostride = 256; u.lstride = 0;
    } else {
        const int j = idx - 1024; const int cc = j & 255, pass = j >> 8, jx = cc >> 3;
        const int st = (cc & 7) + 8 * (2 * pass + (jx >> 4));
        const int br = st >> 6, batch = (st >> 3) & 7, head = st & 7, blk = jx & 15;
        const int dil = br == 0 ? 1 : (br == 1 ? 4 : 16); const int nbr = 16 / dil;
        const int res = blk / nbr, sb = blk % nbr; const int slot0 = sb * 256; const int L = SEQ / dil;
        u.qslot0 = slot0 + 32 * wave;
        const bf16_t* base = A.P + ((size_t)batch * SEQ + res) * PW;
        u.stride = (size_t)dil * PW;
        u.Qp = base + (size_t)u.qslot0 * u.stride + AQ + head * 64; u.Kp = base + AK + head * 64; u.Vp = base + AV + head * 64;
        int t_lo = slot0 / 64 - 1, t_hi = slot0 / 64 + 5; if (t_lo < 0) t_lo = 0; if (t_hi > L / 64) t_hi = L / 64; u.t_lo = t_lo; u.t_hi = t_hi;
        u.negshift = -shA; u.lextra = 0.f; u.isC = 0.f; u.radius = 64;
        const size_t tok = (size_t)batch * SEQ + (size_t)u.qslot0 * dil + res;
        u.orow0 = A.OA + ((size_t)br * NTOK + tok) * 512 + head * 64; u.lrow0 = A.LA + ((size_t)br * NTOK + tok) * 8 + head; u.ostride = dil * 512; u.lstride = dil * 8;
    }
    return u;
}
__device__ __forceinline__ void attn_phase(LAS unsigned char* lds, const AttnArgs& A, int wg, int NWG, int wave, int lane) {
    const int r32 = lane & 31, hi = lane >> 5;
    const float L2E = 1.4426950408889634f;
    float shA = 8.0f * wave_max(fabsf(A.aqn[lane])) * wave_max(fabsf(A.akn[lane])) * L2E; if (shA < 64.f) shA = 0.f;
    float shB = 8.0f * wave_max(fabsf(A.bqn[lane])) * wave_max(fabsf(A.bkn[lane])) * L2E; if (shB < 64.f) shB = 0.f;
    float shC0 = 8.0f * wave_max(fabsf(A.cqn[lane])) * wave_max(fabsf(A.ckn[lane])) * L2E; if (shC0 < 64.f) shC0 = 0.f;
    shA = __builtin_bit_cast(float, __builtin_amdgcn_readfirstlane(__builtin_bit_cast(int, shA)));
    shB = __builtin_bit_cast(float, __builtin_amdgcn_readfirstlane(__builtin_bit_cast(int, shB)));
    shC0 = __builtin_bit_cast(float, __builtin_amdgcn_readfirstlane(__builtin_bit_cast(int, shC0)));
    for (int idx = wg; idx < 512; idx += NWG) {
        f32x16 o[2]; float lsum;
        const int cc = idx & 255, pass = idx >> 8;
        const int pair = (cc & 7) + 8 * pass; const int batch = pair >> 1, g = pair & 1, qb = cc >> 3;
        const int r = wave >> 2, sub = wave & 3, qh = 2 * g + r;
        const int qslot0 = qb * 128 + sub * 32;
        const bf16_t* base = A.P + (size_t)batch * SEQ * PW;
        const bf16_t* Qp = base + (size_t)qslot0 * PW + BQ + qh * 64;
        const bf16_t* Kp = base + BK + g * 64;
        const bf16_t* Vp = base + BV + g * 64;
        if (shB != 0.f) attn_core<false, true>(lds, Kp, Vp, PW, Qp, PW, qslot0, 0, 64, 0, -shB, o, lsum, wave);
        else attn_core<false, false>(lds, Kp, Vp, PW, Qp, PW, qslot0, 0, 64, 0, 0.f, o, lsum, wave);
        const float l = lsum + __shfl_xor(lsum, 32);
        bf16_t* orow0 = A.OB + ((size_t)batch * SEQ + qslot0) * 256 + qh * 64;
        store_o(lds + 98304 + wave * 4096, orow0, 256, o, 1.0f / l, lane);
    }
    {
        const int lane = lane_id_fresh(), r32 = lane & 31, hi = lane >> 5;
        const int tid = wave * 64 + lane; const int srow = tid >> 3, sch = tid & 7;
        const unsigned kw = (unsigned)(sch * 1024 + ((srow ^ sch) * 16));
        const unsigned vw0 = (unsigned)(8192 + (sch >> 2) * 4096 + (srow >> 4) * 1024 + (srow & 15) * 64 + (sch & 3) * 16);
        const unsigned voff = (unsigned)(((lane >> 4) & 1) * 32 + (lane & 3) * 8 + (4 * hi + ((lane & 15) >> 2)) * 64);
        u32x4 st[12]; bf16x8 qn[4];
        int idx = 512 + wg;
        if (idx < 4096) { const BandUnit nu = band_decode(A, idx, wave, shA, shC0); band_issue(nu, srow, sch, st, qn, r32, hi); }
        for (; idx < 4096; idx += NWG) {
            const BandUnit u = band_decode(A, idx, wave, shA, shC0);
            bf16x8 qf[4];
#pragma unroll
            for (int d0 = 0; d0 < 4; ++d0) qf[d0] = qn[d0];
#pragma unroll
            for (int j = 0; j < 6; ++j) { *(LAS u32x4*)(lds + j * 16384 + kw) = st[2 * j]; *(LAS u32x4*)(lds + j * 16384 + vw0) = st[2 * j + 1]; }
            __syncthreads();
            if (idx + NWG < 4096) { const BandUnit nu = band_decode(A, idx + NWG, wave, shA, shC0); band_issue(nu, srow, sch, st, qn, r32, hi); }
            f32x16 o[2]; float lsum;
            band_compute(lds, u, qf, r32, hi, voff, o, lsum);
            const float l = lsum + __shfl_xor(lsum, 32) + u.lextra;
            store_o(lds + 98304 + wave * 4096, u.orow0, (size_t)u.ostride, o, (u.isC != 0.f) ? 1.0f / l : 1.0f, lane);
            if (u.isC == 0.f && hi == 0) u.lrow0[(size_t)r32 * u.lstride] = l;
            __syncthreads();
        }
    }
}
__device__ __forceinline__ void combine_phase(const bf16_t* OA, const float* LA, const bf16_t* OB, const bf16_t* OC, const float* gg, bf16_t* CAT, int gw, int NGW, int lane) {
    const f32x4 ga0 = ((const f32x4*)gg)[lane * 2], ga1 = ((const f32x4*)gg)[lane * 2 + 1];
    const f32x4 gb = ((const f32x4*)(gg + 512))[lane], gc = ((const f32x4*)(gg + 768))[lane];
    const int head = lane >> 3;
    for (int m0 = gw * 2; m0 < NTOK; m0 += NGW * 2) {
        u32x4 wa[2][3]; float la[2][3]; u32x2 wb[2], wc[2];
#pragma unroll
        for (int u = 0; u < 2; ++u) { const int m = m0 + u;
#pragma unroll
            for (int br = 0; br < 3; ++br) { la[u][br] = LA[((size_t)br * NTOK + m) * 8 + head]; wa[u][br] = *(const u32x4*)(OA + ((size_t)br * NTOK + m) * 512 + lane * 8); }
            wb[u] = *(const u32x2*)(OB + (size_t)m * 256 + lane * 4); wc[u] = *(const u32x2*)(OC + (size_t)m * 256 + lane * 4); }
#pragma unroll
        for (int u = 0; u < 2; ++u) { const int m = m0 + u;
            float v[8];
#pragma unroll
            for (int i = 0; i < 8; ++i) v[i] = 0.f;
#pragma unroll
            for (int br = 0; br < 3; ++br) { const u32x4 w = wa[u][br];
                v[0] += bflo(w.x); v[1] += bfhi(w.x); v[2] += bflo(w.y); v[3] += bfhi(w.y); v[4] += bflo(w.z); v[5] += bfhi(w.z); v[6] += bflo(w.w); v[7] += bfhi(w.w); }
            const float il = 1.0f / ((la[u][0] + la[u][1]) + la[u][2]); float ss = 0.f;
#pragma unroll
            for (int i = 0; i < 8; ++i) { v[i] *= il; ss += v[i] * v[i]; }
            const float b0 = bflo(wb[u].x), b1 = bfhi(wb[u].x), b2 = bflo(wb[u].y), b3 = bfhi(wb[u].y);
            const float c0 = bflo(wc[u].x), c1 = bfhi(wc[u].x), c2 = bflo(wc[u].y), c3 = bfhi(wc[u].y);
            float sb = (b0 * b0 + b1 * b1) + (b2 * b2 + b3 * b3), sc = (c0 * c0 + c1 * c1) + (c2 * c2 + c3 * c3);
#pragma unroll
            for (int o = 1; o < 64; o <<= 1) { ss += __shfl_xor(ss, o); sb += __shfl_xor(sb, o); sc += __shfl_xor(sc, o); }
            const float ra = 1.0f / sqrtf(ss * (1.0f / 512.0f) + EPS), rb = 1.0f / sqrtf(sb * (1.0f / 256.0f) + EPS), rc = 1.0f / sqrtf(sc * (1.0f / 256.0f) + EPS);
            u32x4 wo; wo.x = pk2(v[0] * ra * ga0.x, v[1] * ra * ga0.y); wo.y = pk2(v[2] * ra * ga0.z, v[3] * ra * ga0.w);
            wo.z = pk2(v[4] * ra * ga1.x, v[5] * ra * ga1.y); wo.w = pk2(v[6] * ra * ga1.z, v[7] * ra * ga1.w);
            *(u32x4*)(CAT + (size_t)m * DM + lane * 8) = wo;
            u32x2 q; q.x = pk2(b0 * rb * gb.x, b1 * rb * gb.y); q.y = pk2(b2 * rb * gb.z, b3 * rb * gb.w);
            *(u32x2*)(CAT + (size_t)m * DM + 512 + lane * 4) = q;
            u32x2 r; r.x = pk2(c0 * rc * gc.x, c1 * rc * gc.y); r.y = pk2(c2 * rc * gc.z, c3 * rc * gc.w);
            *(u32x2*)(CAT + (size_t)m * DM + 768 + lane * 4) = r;
        }
    }
}

#define GAS __attribute__((address_space(1)))
#define XB_TMO      128
#define XB_XCNT(j)  (256  + 64 * (j))
#define XB_XSUB(j)  (1280 + 64 * (j))
#define XB_XGEN(j)  (2304 + 64 * (j))
#define XB_TOP      3328
#define XB_TOPGEN   3392
#define XCD_BAR_WORDS 3456
#define XB_SPIN_CAP (1u << 18)

__device__ __forceinline__ unsigned xb_ld(unsigned* p)              { return __hip_atomic_load(p, __ATOMIC_RELAXED, __HIP_MEMORY_SCOPE_AGENT); }
__device__ __forceinline__ unsigned xb_add(unsigned* p, unsigned v) { return __hip_atomic_fetch_add(p, v, __ATOMIC_RELAXED, __HIP_MEMORY_SCOPE_AGENT); }
__device__ __forceinline__ unsigned xb_xcc_id() { return (unsigned)__builtin_amdgcn_s_getreg((3 << 11) | 20) & 0xFu; }
#define XB_SPIN(cond, bar) do { unsigned _sp = 0; while (cond) { __builtin_amdgcn_s_sleep(1); \
    if ((++_sp & 255u) == 0u) { if (xb_ld(&(bar)[XB_TMO])) break; if (_sp > XB_SPIN_CAP) { atomicAdd(&(bar)[XB_TMO], 1u); break; } } } } while (0)

struct XcdBarrier {
    unsigned* bar; unsigned x;
    volatile LAS unsigned* st;
};

__device__ __forceinline__ XcdBarrier xcd_barrier_post(unsigned* bar, volatile LAS unsigned* st, const int tid0) {
    XcdBarrier b; b.bar = bar; b.x = xb_xcc_id(); b.st = st;
    if (tid0 == 0) (void)xb_add(&bar[XB_XCNT(b.x)], 1u);
    return b;
}
__device__ __forceinline__ void xcd_barrier_complete(unsigned* bar, unsigned x, unsigned& nloc, unsigned& nx) {
    const unsigned G = gridDim.x * gridDim.y * gridDim.z;
    unsigned sum, cnt, mine, sp = 0u;
    for (;;) {
        sum = 0u; cnt = 0u; mine = 0u;
#pragma unroll
        for (unsigned j = 0; j < 16; ++j) { const unsigned c = xb_ld(&bar[XB_XCNT(j)]); sum += c; cnt += (c > 0u) ? 1u : 0u; mine = (j == x) ? c : mine; }
        if (sum == G) break;
        __builtin_amdgcn_s_sleep(1);
        if ((++sp & 255u) == 0u) { if (xb_ld(&bar[XB_TMO])) break; if (sp > XB_SPIN_CAP) { atomicAdd(&bar[XB_TMO], 1u); break; } }
    }
    nloc = mine > 0u ? mine : 1u; nx = cnt > 0u ? cnt : 1u;
}

__device__ __forceinline__ void xcd_barrier(const XcdBarrier& b, const int tid0) {
    asm volatile("s_waitcnt vmcnt(0)" ::: "memory");
    __syncthreads();
    if (tid0 == 0) {
        unsigned* bar = b.bar;
        __builtin_amdgcn_s_waitcnt(0);
        unsigned nloc = b.st[0], nx = b.st[1];
        if (nloc == 0u) { xcd_barrier_complete(bar, b.x, nloc, nx); b.st[0] = nloc; b.st[1] = nx; }
        const unsigned old = xb_add(&bar[XB_XSUB(b.x)], 1u);
        const unsigned gen = old / nloc;
        if (old + 1u == (gen + 1u) * nloc) {
            __builtin_amdgcn_fence(__ATOMIC_RELEASE, "agent");
            asm volatile("s_waitcnt vmcnt(0)" ::: "memory");
            const unsigned og = xb_add(&bar[XB_TOP], 1u);
            const unsigned tg = og / nx;
            if (og + 1u == (tg + 1u) * nx) xb_add(&bar[XB_TOPGEN], 1u);
            else XB_SPIN(xb_ld(&bar[XB_TOPGEN]) == tg, bar);
            __builtin_amdgcn_fence(__ATOMIC_ACQUIRE, "agent");
            xb_add(&bar[XB_XGEN(b.x)], 1u);
            asm volatile("s_waitcnt vmcnt(0)" ::: "memory");
        } else {
            XB_SPIN(xb_ld(&bar[XB_XGEN(b.x)]) == gen, bar);
            __builtin_amdgcn_fence(__ATOMIC_ACQUIRE, "agent");
            asm volatile("s_waitcnt vmcnt(0)" ::: "memory");
        }
    }
    __syncthreads();
}

__device__ __forceinline__ void finalize_rs(const float* ssp, float* rs, int gtid, int NGT) {
    for (int i = gtid; i < NTOK; i += NGT) { const f32x4* p = (const f32x4*)(ssp + (size_t)i * 16);
        const f32x4 a = p[0], b = p[1], c = p[2], d = p[3];
        const float s = (((a[0] + a[1]) + (a[2] + a[3])) + ((b[0] + b[1]) + (b[2] + b[3]))) + (((c[0] + c[1]) + (c[2] + c[3])) + ((d[0] + d[1]) + (d[2] + d[3])));
        rs[i] = 1.0f / sqrtf(s * (1.0f / DM) + EPS); }
}
struct Args { const float* in[20]; float* out; unsigned char* ws; };
typedef const volatile Args __attribute__((address_space(4))) * kargp_t;
#define KARG() ((kargp_t)__builtin_amdgcn_kernarg_segment_ptr())
#define LD_IN(i) ((const float*)KARG()->in[i])
#define LD_WS() ((unsigned char*)KARG()->ws)
#define LD_OUT() ((float*)KARG()->out)
__global__ void __launch_bounds__(NTHREADS, 2) fwd_megakernel(Args a_unused) {
    extern __shared__ __attribute__((aligned(16))) unsigned char lds_raw[];
    LAS unsigned char* lds = (LAS unsigned char*)lds_raw;
    cg::grid_group grid = cg::this_grid();
    const int G = gridDim.x, wg = blockIdx.x;
    const int NGW = G * NWAVES;
    const int wave0 = __builtin_amdgcn_readfirstlane(threadIdx.x >> 6);
#define FRESH() const int wave = fresh_wave(wave0), tid = fresh_tid(wave), lane = tid & 63, gw = wg * NWAVES + wave; (void)lane; (void)gw
    volatile LAS unsigned* bst = (volatile LAS unsigned*)(lds + 131072 + 512);
    {   unsigned* barw = (unsigned*)(LD_WS() + 0);
        if (threadIdx.x < 2) bst[threadIdx.x] = 0u;
        if (wg == 0) for (int i = threadIdx.x; i < XCD_BAR_WORDS; i += NTHREADS) barw[i] = 0u;
        __syncthreads(); }
    {
        FRESH();
        unsigned char* ws = LD_WS();
        LAS float* scr = (LAS float*)(lds + wave * 16384);
        for (int l = 0; l < NLAYER; ++l) {
            unsigned char* wl = ws + WS_W + (size_t)l * W_LAYER;
            const float* g1 = LD_IN(1) + (size_t)l * DM; const float* gm = LD_IN(5) + (size_t)l * DM; const float* g2 = LD_IN(16) + (size_t)l * DM;
            transpose_matrix(LD_IN(2) + (size_t)l * DM * DFF, DM, DFF, (bf16_t*)(wl + WO_GU1), 1, g1, scr, gw, NGW, lane);
            transpose_matrix(LD_IN(3) + (size_t)l * DM * DFF, DM, DFF, (bf16_t*)(wl + WO_GU1), 2, g1, scr, gw, NGW, lane);
            transpose_matrix(LD_IN(4) + (size_t)l * DFF * DM, DFF, DM, (bf16_t*)(wl + WO_D1), 0, nullptr, scr, gw, NGW, lane);
            transpose_matrix(LD_IN(6) + (size_t)l * DM * PW, DM, PW, (bf16_t*)(wl + WO_IN), 3, gm, scr, gw, NGW, lane);
            transpose_matrix(LD_IN(15) + (size_t)l * DM * DM, DM, DM, (bf16_t*)(wl + WO_OUT), 0, nullptr, scr, gw, NGW, lane);
            transpose_matrix(LD_IN(17) + (size_t)l * DM * DFF, DM, DFF, (bf16_t*)(wl + WO_GU2), 1, g2, scr, gw, NGW, lane);
            transpose_matrix(LD_IN(18) + (size_t)l * DM * DFF, DM, DFF, (bf16_t*)(wl + WO_GU2), 2, g2, scr, gw, NGW, lane);
            transpose_matrix(LD_IN(19) + (size_t)l * DFF * DM, DFF, DM, (bf16_t*)(wl + WO_D2), 0, nullptr, scr, gw, NGW, lane);
        }
        rope_tables((float*)(ws + WS_COS1), (float*)(ws + WS_SIN1), (float*)(ws + WS_COSX), (float*)(ws + WS_SINX), wg * NTHREADS + tid, G * NTHREADS);
        x_prep(LD_IN(0), (bf16_t*)(ws + WS_H), (float*)(ws + WS_RS), gw, NGW, lane);
    }
    grid.sync();
    const XcdBarrier xbar = xcd_barrier_post((unsigned*)(LD_WS() + 0), bst, fresh_tid(wave0));
#define GSYNC() xcd_barrier(xbar, fresh_tid(wave0))
#define GEMM_PHASE(EPI, Aoff, Woff, N_, K_, ...) do { unsigned char* ws = LD_WS(); unsigned char* wl = ws + WS_W + (size_t)l * W_LAYER; \
        pg8::Gemm g{(const bf16_t*)(ws + (Aoff)), (const bf16_t*)(wl + (Woff)), NTOK, (N_), (K_)}; pg8::StaticOrder S; S.init(NTOK, (N_), G, fresh_wave(wg)); \
        pg8::EPI E{__VA_ARGS__}; pg8::gemm_phase<pg8::EPI, pg8::StaticOrder, true, true>(lds, g, S, E, wave0); } while (0)
#define FINALIZE() do { FRESH(); unsigned char* ws = LD_WS(); finalize_rs((const float*)(ws + WS_SS), (float*)(ws + WS_RS), wg * NTHREADS + tid, G * NTHREADS); } while (0)

#pragma nounroll
    for (int l = 0; l < NLAYER; ++l) {
        const bool lastl = (l + 1 == NLAYER);
        GEMM_PHASE(EpiSwiglu, WS_H, WO_GU1, 2 * DFF, DM, (bf16_t*)(ws + WS_U), DFF, (const float*)(ws + WS_RS));
        GSYNC();
        GEMM_PHASE(EpiResid, WS_U, WO_D1, DM, DFF, (bf16_t*)(ws + WS_H), (float*)nullptr, DM, 0.5f, (float*)(ws + WS_SS), (const float*)(ws + WS_RS), -0.6931471805599453f);
        GSYNC(); FINALIZE(); GSYNC();
        GEMM_PHASE(EpiQKV, WS_H, WO_IN, PW, DM, (bf16_t*)(ws + WS_PROJ), (const float*)(ws + WS_RS), LD_IN(7) + l * 64, LD_IN(8) + l * 64, LD_IN(9) + l * 64, LD_IN(10) + l * 64, LD_IN(11) + l * 64, LD_IN(12) + l * 64,
                   (const float*)(ws + WS_COS1), (const float*)(ws + WS_SIN1), (const float*)(ws + WS_COSX), (const float*)(ws + WS_SINX), QSCALE);
        GSYNC();
        { FRESH(); unsigned char* ws = LD_WS();
          AttnArgs A{(const bf16_t*)(ws + WS_PROJ), (bf16_t*)(ws + WS_ATTA), (bf16_t*)(ws + WS_ATTB), (bf16_t*)(ws + WS_ATTC), (float*)(ws + WS_LA),
                     LD_IN(7) + l * 64, LD_IN(8) + l * 64, LD_IN(9) + l * 64, LD_IN(10) + l * 64, LD_IN(11) + l * 64, LD_IN(12) + l * 64, LD_IN(13) + l * 4};
          attn_phase(lds, A, fresh_wave(wg), G, wave, lane); }
        GSYNC();
        { FRESH(); unsigned char* ws = LD_WS();
          combine_phase((const bf16_t*)(ws + WS_ATTA), (const float*)(ws + WS_LA), (const bf16_t*)(ws + WS_ATTB), (const bf16_t*)(ws + WS_ATTC), LD_IN(14) + (size_t)l * DM, (bf16_t*)(ws + WS_CAT), gw, NGW, lane); }
        GSYNC();
        GEMM_PHASE(EpiResid, WS_CAT, WO_OUT, DM, DM, (bf16_t*)(ws + WS_H), (float*)nullptr, DM, 1.0f, (float*)(ws + WS_SS), (const float*)nullptr, 1.0f);
        GSYNC(); FINALIZE(); GSYNC();
        GEMM_PHASE(EpiSwiglu, WS_H, WO_GU2, 2 * DFF, DM, (bf16_t*)(ws + WS_U), DFF, (const float*)(ws + WS_RS));
        GSYNC();
        GEMM_PHASE(EpiResid, WS_U, WO_D2, DM, DFF, (bf16_t*)(ws + WS_H), lastl ? LD_OUT() : (float*)nullptr, DM, 0.5f, (float*)(ws + WS_SS), (const float*)(ws + WS_RS), -0.6931471805599453f);
        if (!lastl) { GSYNC(); FINALIZE(); GSYNC(); }
    }
}

extern "C" void kernel_launch(void* const* d_in, const int* in_sizes, int n_in, void* d_out, int out_size, void* d_ws, size_t ws_size, hipStream_t stream) {
    static int grid = 0;
    if (grid == 0) {
        if (n_in != 20 || out_size != NTOK * DM || ws_size < WS_END) { fprintf(stderr, "kernel_launch: unexpected shapes (n_in %d out %d ws %zu)\n", n_in, out_size, ws_size); grid = -1; return; }
        int dev = 0, cus = 0, per_cu = 0;
        hipGetDevice(&dev); hipDeviceGetAttribute(&cus, hipDeviceAttributeMultiprocessorCount, dev);
        hipFuncSetAttribute((const void*)fwd_megakernel, hipFuncAttributeMaxDynamicSharedMemorySize, LDS_BYTES);
        hipOccupancyMaxActiveBlocksPerMultiprocessor(&per_cu, (const void*)fwd_megakernel, NTHREADS, LDS_BYTES);
        if (per_cu < 1) { fprintf(stderr, "kernel_launch: occupancy query says %d blocks/CU\n", per_cu); per_cu = 1; }
        (void)hipGetLastError();
        grid = cus;
    }
    if (grid < 0) return;
    Args a{};
    for (int i = 0; i < 20; ++i) a.in[i] = (const float*)d_in[i];
    a.out = (float*)d_out; a.ws = (unsigned char*)d_ws;
    void* args[] = {&a};
    hipError_t e = hipLaunchCooperativeKernel((const void*)fwd_megakernel, dim3(grid), dim3(NTHREADS), args, LDS_BYTES, stream);
    if (e != hipSuccess) fprintf(stderr, "cooperative launch failed: %s (grid %d)\n", hipGetErrorString(e), grid);
}
```

```cpp
#include <hip/hip_runtime.h>
#include <hip/hip_cooperative_groups.h>
#include <cstdio>
#include <cstdint>
namespace cg = cooperative_groups;
__device__ __forceinline__ int lane_id_fresh() { unsigned z; asm volatile("s_mov_b32 %0, 0" : "=s"(z)); return (int)__builtin_amdgcn_mbcnt_hi(~0u, __builtin_amdgcn_mbcnt_lo(~0u, z)); }
__device__ __forceinline__ int fresh_wave(int w) { asm volatile("" : "+s"(w)); return w; }
namespace pg8 {
#define PG8_LAS __attribute__((address_space(3)))
typedef unsigned short bf16_t;
typedef short bf16x8 __attribute__((ext_vector_type(8)));
typedef float f32x4 __attribute__((ext_vector_type(4)));
typedef unsigned u32x4 __attribute__((ext_vector_type(4)));
constexpr int BM = 256, BK = 64, HALF = 128, HTB = HALF * BK * 2  , STAGE_BYTES = 8 * HTB, NXCD = 8, WGM = 8;

__host__ __device__ __forceinline__ int lds_byte(int r, int c) { const int st = (r >> 4) * 2 + (c >> 5), rr = r & 15, cc = c & 31, ob = rr * 64 + cc * 2; return st * 1024 + (ob ^ (((ob >> 9) & 1) << 5)); }
__host__ __device__ __forceinline__ void stage_rc(int b, int& R, int& C) { const int st = b / 1024, sb = b % 1024, swz = sb ^ (((sb >> 9) & 1) << 5); R = (st >> 1) * 16 + swz / 64; C = (st & 1) * 32 + (swz % 64) / 2; }
__host__ __device__ __forceinline__ int perm32(int rho) { const int n = rho >> 4, i = rho & 15; return 8 * (i >> 2) + 4 * n + (i & 3); }

struct Unit { int pm, pn; };
struct Gemm { const bf16_t* A; const bf16_t* Bt; int M, N, K; };

struct StaticOrder {
    int nM, nN, nwg, G, c;
    __host__ __device__ void init(int M, int N, int G_, int c_) { nM = M / BM; nN = N / BM; nwg = nM * nN; G = G_; c = c_; }
    __host__ __device__ bool next(int i, Unit& u) const {
        const long L = (long)i * G + c; if (L >= nwg) return false;
        int wgid = (int)L; { const int q = nwg / NXCD, r = nwg % NXCD, xcd = wgid % NXCD, off = wgid / NXCD; wgid = (xcd < r ? xcd * (q + 1) : r * (q + 1) + (xcd - r) * q) + off; }
        const int nig = WGM * nN, gid = wgid / nig, fm = gid * WGM, gsz = (nM - fm) < WGM ? (nM - fm) : WGM;
        u.pm = fm + ((wgid % nig) % gsz); u.pn = (wgid % nig) / gsz; return true;
    }
    __device__ __forceinline__ void a_ready(const Unit&) const {}
    __device__ __forceinline__ void done(const Unit&) const {}
};

__device__ __forceinline__ unsigned cvt_pk_bf16(float lo, float hi) { unsigned r; asm volatile("v_cvt_pk_bf16_f32 %0, %1, %2" : "=v"(r) : "v"(lo), "v"(hi)); return r; }
typedef float f32x2 __attribute__((ext_vector_type(2)));
__device__ __forceinline__ f32x2 gelu_pk(f32x2 v) {
    const f32x2 av = __builtin_elementwise_abs(v), d = av * 0.2316418882f + 1.0f;
    f32x2 t; t.x = __builtin_amdgcn_rcpf(d.x); t.y = __builtin_amdgcn_rcpf(d.y);
    f32x2 q = t * 0.5307027145f + (-0.7265760135f); q = q * t + 0.7107068705f; q = q * t + (-0.142248368f); q = q * t + 0.127414796f; q = q * t;
    const f32x2 s = (v * v) * (-0.72134752044f);
    f32x2 e; e.x = __builtin_amdgcn_exp2f(s.x); e.y = __builtin_amdgcn_exp2f(s.y);
    const f32x2 m = v * (q * e), r = v - m;
    f32x2 o; o.x = v.x < 0.f ? m.x : r.x; o.y = v.y < 0.f ? m.y : r.y; return o;
}

template <int ACT  > struct EpiBf16 {
    static constexpr bool PERM = true, AFTER_DRAIN = false; static_assert(ACT == 0 || ACT == 1, "EpiBf16: ACT is 0 (none) or 1 (gelu_pk)");
    bf16_t* O; int ldc; const float* bias; int split_cols; size_t split_stride; float scale0;
    __device__ __forceinline__ void operator()(const f32x4 (&acc)[2][2][4][2], const Unit& u, int wr, int wc, int fr, int fq) const {
        const int row0 = u.pm * BM + wr * 64 + fr; int colt = u.pn * BM; bf16_t* base = O;
        float sc = 1.f; if (split_cols) { const int t = colt / split_cols; base += (size_t)t * split_stride; colt -= t * split_cols; if (t == 0) sc = scale0; }
        const int col0 = colt + wc * 32 + 8 * fq, bcol0 = u.pn * BM + wc * 32 + 8 * fq;
        f32x4 bv[2][2];
#pragma unroll
        for (int bj = 0; bj < 2; ++bj)
#pragma unroll
            for (int n = 0; n < 2; ++n) bv[bj][n] = bias ? *(const f32x4*)(bias + bcol0 + bj * HALF + 4 * n) : (f32x4){0.f, 0.f, 0.f, 0.f};
#pragma unroll
        for (int ai = 0; ai < 2; ++ai)
#pragma unroll
            for (int m = 0; m < 4; ++m) { bf16_t* rowp = base + (size_t)(row0 + ai * HALF + m * 16) * ldc + col0;
#pragma unroll
                for (int bj = 0; bj < 2; ++bj) { f32x4 v0 = acc[ai][bj][m][0] + bv[bj][0], v1 = acc[ai][bj][m][1] + bv[bj][1];
                    if (ACT == 1) { f32x2 a = gelu_pk((f32x2){v0[0], v0[1]}), b = gelu_pk((f32x2){v0[2], v0[3]}), c = gelu_pk((f32x2){v1[0], v1[1]}), d = gelu_pk((f32x2){v1[2], v1[3]});
                        v0 = (f32x4){a.x, a.y, b.x, b.y}; v1 = (f32x4){c.x, c.y, d.x, d.y}; }
                    v0 = v0 * sc; v1 = v1 * sc; u32x4 w; w.x = cvt_pk_bf16(v0[0], v0[1]); w.y = cvt_pk_bf16(v0[2], v0[3]); w.z = cvt_pk_bf16(v1[0], v1[1]); w.w = cvt_pk_bf16(v1[2], v1[3]);
                    *(u32x4*)(rowp + bj * HALF) = w; } }
    }
};
typedef unsigned u32x2 __attribute__((ext_vector_type(2)));
struct EpiSwiglu {
    static constexpr bool PERM = true, AFTER_DRAIN = false;
    bf16_t* O; int ldc; const float* ss;
    __device__ __forceinline__ void operator()(const f32x4 (&acc)[2][2][4][2], const Unit& u, int wr, int wc, int fr, int fq) const {
        const int row0 = u.pm * BM + wr * 64 + fr; const int col0 = u.pn * HALF + wc * 32 + 8 * fq;
#pragma unroll
        for (int ai = 0; ai < 2; ++ai)
#pragma unroll
            for (int m = 0; m < 4; ++m) {
                const int row = row0 + ai * HALF + m * 16;
                const float rs = ss[row];
                bf16_t* rowp = O + (size_t)row * ldc + col0;
                float v[8];
#pragma unroll
                for (int n = 0; n < 2; ++n)
#pragma unroll
                    for (int i = 0; i < 4; ++i) { const float ag = acc[ai][0][m][n][i], au = acc[ai][1][m][n][i];
                        const float e = __builtin_amdgcn_exp2f(ag * rs);
                        v[n * 4 + i] = (ag * au) * __builtin_amdgcn_rcpf(1.0f + e); }
                u32x4 w; w.x = cvt_pk_bf16(v[0], v[1]); w.y = cvt_pk_bf16(v[2], v[3]); w.z = cvt_pk_bf16(v[4], v[5]); w.w = cvt_pk_bf16(v[6], v[7]);
                *(u32x4*)rowp = w;
            }
    }
};
struct EpiResid {
    static constexpr bool PERM = true, AFTER_DRAIN = false;
    bf16_t* xb; float* fout; int ldc; float scale; float* ssout; const float* rowrs; float rowk;
    __device__ __forceinline__ void operator()(const f32x4 (&acc)[2][2][4][2], const Unit& u, int wr, int wc, int fr, int fq) const {
        const int row0 = u.pm * BM + wr * 64 + fr; const int col0 = u.pn * BM + wc * 32 + 8 * fq;
#pragma unroll
        for (int ai = 0; ai < 2; ++ai) {
            u32x4 b[4][2];
#pragma unroll
            for (int m = 0; m < 4; ++m) { const size_t off = (size_t)(row0 + ai * HALF + m * 16) * ldc + col0;
#pragma unroll
                for (int bj = 0; bj < 2; ++bj) b[m][bj] = *(const u32x4*)(xb + off + bj * HALF); }
            asm volatile("" ::: "memory");
            float sm[4];
#pragma unroll
            for (int m = 0; m < 4; ++m) { const int row = row0 + ai * HALF + m * 16; const size_t off = (size_t)row * ldc + col0; float s = 0.f;
                float sc = scale; if (rowrs) { const float r_ = rowrs[row]; sc = scale * rowk * r_ * r_; }
#pragma unroll
                for (int bj = 0; bj < 2; ++bj) { const u32x4 w = b[m][bj];
                    f32x4 r0 = {__builtin_bit_cast(float, w.x << 16), __builtin_bit_cast(float, w.x & 0xffff0000u), __builtin_bit_cast(float, w.y << 16), __builtin_bit_cast(float, w.y & 0xffff0000u)};
                    f32x4 r1 = {__builtin_bit_cast(float, w.z << 16), __builtin_bit_cast(float, w.z & 0xffff0000u), __builtin_bit_cast(float, w.w << 16), __builtin_bit_cast(float, w.w & 0xffff0000u)};
                    r0 = r0 + acc[ai][bj][m][0] * sc; r1 = r1 + acc[ai][bj][m][1] * sc;
                    if (fout) { *(f32x4*)(fout + off + bj * HALF) = r0; *(f32x4*)(fout + off + bj * HALF + 4) = r1; }
                    else { s += (r0[0] * r0[0] + r0[1] * r0[1]) + (r0[2] * r0[2] + r0[3] * r0[3]) + (r1[0] * r1[0] + r1[1] * r1[1]) + (r1[2] * r1[2] + r1[3] * r1[3]);
                        u32x4 o; o.x = cvt_pk_bf16(r0[0], r0[1]); o.y = cvt_pk_bf16(r0[2], r0[3]); o.z = cvt_pk_bf16(r1[0], r1[1]); o.w = cvt_pk_bf16(r1[2], r1[3]);
                        *(u32x4*)(xb + off + bj * HALF) = o; } }
                sm[m] = s; }
            if (!fout) {
#pragma unroll
                for (int m = 0; m < 4; ++m) sm[m] += __shfl_xor(sm[m], 16);
#pragma unroll
                for (int m = 0; m < 4; ++m) sm[m] += __shfl_xor(sm[m], 32);
#pragma unroll
                for (int m = 0; m < 4; ++m) if (fq == 0) ssout[(size_t)(row0 + ai * HALF + m * 16) * 16 + u.pn * 4 + wc] = sm[m]; }
            asm volatile("" ::: "memory");
        }
    }
};
struct EpiQKV {
    static constexpr bool PERM = true, AFTER_DRAIN = false;
    bf16_t* O; const float* ss; const float *aqn, *akn, *bqn, *bkn, *cqn, *ckn; const float *cos1, *sin1, *cosx, *sinx; float qscale;
    __device__ __forceinline__ void operator()(const f32x4 (&acc)[2][2][4][2], const Unit& u, int wr, int wc, int fr, int fq) const {
        const int hidx = 4 * u.pn + wc;
        int kind = 0; const float* gp = aqn; bool isq = false;
        if (hidx < 8) { kind = 1; gp = aqn; isq = true; } else if (hidx < 16) { kind = 1; gp = akn; }
        else if (hidx < 24) { kind = 0; } else if (hidx < 28) { kind = 2; gp = bqn; isq = true; } else if (hidx < 30) { kind = 2; gp = bkn; }
        else if (hidx < 32) { kind = 0; } else if (hidx < 36) { kind = 1; gp = cqn; isq = true; } else if (hidx < 38) { kind = 1; gp = ckn; }
        const int row0 = u.pm * BM + wr * 64 + fr;
        bf16_t* obase = O + hidx * 64 + 8 * fq;
        if (kind == 0) {
            float rsv[8];
#pragma unroll
            for (int g = 0; g < 8; ++g) rsv[g] = ss[row0 + (g >> 2) * HALF + (g & 3) * 16];
#pragma unroll
            for (int g = 0; g < 8; ++g) { const int ai = g >> 2, m = g & 3; const int row = row0 + ai * HALF + m * 16; const float rs = rsv[g];
#pragma unroll
                for (int bj = 0; bj < 2; ++bj) { const f32x4 x0 = acc[ai][bj][m][0] * rs, x1 = acc[ai][bj][m][1] * rs;
                    u32x4 w; w.x = cvt_pk_bf16(x0[0], x0[1]); w.y = cvt_pk_bf16(x0[2], x0[3]); w.z = cvt_pk_bf16(x1[0], x1[1]); w.w = cvt_pk_bf16(x1[2], x1[3]);
                    *(u32x4*)(obase + (size_t)row * 2560 + 32 * bj) = w; } }
            return;
        }
        f32x4 gv[2][2];
#pragma unroll
        for (int bj = 0; bj < 2; ++bj)
#pragma unroll
            for (int n = 0; n < 2; ++n) gv[bj][n] = *(const f32x4*)(gp + 32 * bj + (kind == 2 ? 16 * n + 4 * fq : 8 * fq + 4 * n));
        const float hs = isq ? qscale : 1.0f;
        f32x4 tc[1][2], ts[1][2]; float rsb[2];
        auto load_tabs = [&](int g, f32x4 (&c)[2], f32x4 (&sn)[2]) {
            const int t = (row0 + (g >> 2) * HALF + (g & 3) * 16) & 4095; rsb[g & 1] = ss[row0 + (g >> 2) * HALF + (g & 3) * 16];
            if (kind == 1) {
#pragma unroll
                for (int n = 0; n < 2; ++n) { c[n] = *(const f32x4*)(cos1 + t * 32 + 8 * fq + 4 * n); sn[n] = *(const f32x4*)(sin1 + t * 32 + 8 * fq + 4 * n); }
            } else {
#pragma unroll
                for (int bj = 0; bj < 2; ++bj) { const int pos = bj == 0 ? (t >> 6) : (t & 63); c[bj] = *(const f32x4*)(cosx + pos * 16 + 4 * fq); sn[bj] = *(const f32x4*)(sinx + pos * 16 + 4 * fq); }
            }
        };
        float ssq[8];
#pragma unroll
        for (int g = 0; g < 8; ++g) { const int ai = g >> 2, m = g & 3; float q = 0.f;
#pragma unroll
            for (int bj = 0; bj < 2; ++bj)
#pragma unroll
                for (int n = 0; n < 2; ++n) { const f32x4 a = acc[ai][bj][m][n]; q += (a[0] * a[0] + a[1] * a[1]) + (a[2] * a[2] + a[3] * a[3]); }
            ssq[g] = q; }
        load_tabs(0, tc[0], ts[0]);
#pragma unroll
        for (int g = 0; g < 8; ++g) ssq[g] += __shfl_xor(ssq[g], 16);
#pragma unroll
        for (int g = 0; g < 8; ++g) ssq[g] += __shfl_xor(ssq[g], 32);
#pragma unroll
        for (int g = 0; g < 8; ++g) {
            const int ai = g >> 2, m = g & 3;
            const int row = row0 + ai * HALF + m * 16; const float rs = rsb[g & 1];
            const float sc = rs * hs / sqrtf(rs * rs * ssq[g] * (1.0f / 64.0f) + 1e-6f);
            f32x4 x[2][2];
#pragma unroll
            for (int bj = 0; bj < 2; ++bj)
#pragma unroll
                for (int n = 0; n < 2; ++n) x[bj][n] = acc[ai][bj][m][n] * sc * gv[bj][n];
            if (kind == 1) {
#pragma unroll
                for (int n = 0; n < 2; ++n) { const f32x4 c = tc[0][n], sn = ts[0][n];
                    const f32x4 o0 = x[0][n] * c - x[1][n] * sn, o1 = x[1][n] * c + x[0][n] * sn; x[0][n] = o0; x[1][n] = o1; }
            } else {
#pragma unroll
                for (int bj = 0; bj < 2; ++bj) { const f32x4 c = tc[0][bj], sn = ts[0][bj];
                    const f32x4 o0 = x[bj][0] * c - x[bj][1] * sn, o1 = x[bj][1] * c + x[bj][0] * sn; x[bj][0] = o0; x[bj][1] = o1; }
            }
            asm volatile("" ::: "memory");
            if (g + 1 < 8) load_tabs(g + 1, tc[0], ts[0]);
            asm volatile("" ::: "memory");
#pragma unroll
            for (int bj = 0; bj < 2; ++bj) { u32x4 w; w.x = cvt_pk_bf16(x[bj][0][0], x[bj][0][1]); w.y = cvt_pk_bf16(x[bj][0][2], x[bj][0][3]);
                w.z = cvt_pk_bf16(x[bj][1][0], x[bj][1][1]); w.w = cvt_pk_bf16(x[bj][1][2], x[bj][1][3]);
                *(u32x4*)(obase + (size_t)row * 2560 + 32 * bj) = w; }
        }
    }
};
template <class Epi, class Sched, bool ALIGN_EPI = false, bool SP2 = false>
__device__ __forceinline__ void gemm_phase(PG8_LAS unsigned char* lds, const Gemm g, const Sched& S, const Epi& E, const int wave0_) {
    const int wave0 = fresh_wave(wave0_);
    const int tid = wave0 * 64 + lane_id_fresh(), wid = wave0, lane = tid & 63, wr = wid >> 2, wc = wid & 3, fr = lane & 15, fq = lane >> 4;
    const int K = g.K, nt = K / BK;
    unsigned voffA[2], voffB[2];
#pragma unroll
    for (int i = 0; i < 2; ++i) { int R, C; stage_rc(tid * 16 + i * 8192, R, C); const int Rb = Epi::PERM ? ((R & ~31) + perm32(R & 31)) : R;
        voffA[i] = (unsigned)(R * K + C) * 2u; voffB[i] = (unsigned)(Rb * K + C) * 2u; }
    const size_t kstep = (size_t)(BK * 2);
    const size_t hstep = (size_t)HALF * K * 2;
    const size_t tstep = 2 * hstep;
    const unsigned ldsw = (unsigned)wid * 1024u;
    const int aoff = lds_byte(wr * 64 + fr, fq * 8), boff = lds_byte(wc * 32 + fr, fq * 8);
#define PG8_SA(b, h) (((b) * 2 + (h)) * HTB)
#define PG8_SB(b, h) ((4 + (b) * 2 + (h)) * HTB)
#define PG8_STAGE(bufoff, gbase, voff) do { _Pragma("unroll") for (int _i = 0; _i < 2; ++_i) \
        __builtin_amdgcn_global_load_lds((const unsigned*)((const char*)(gbase) + (voff)[_i]), (PG8_LAS unsigned*)(lds + (bufoff) + ldsw + _i * 8192), 16, 0, 0); } while (0)
#define PG8_LDA(dst, b, h) do { _Pragma("unroll") for (int m = 0; m < 4; ++m) _Pragma("unroll") for (int k = 0; k < 2; ++k) dst[m][k] = *(const PG8_LAS bf16x8*)(lds + PG8_SA(b, h) + aoff + m * 2048 + k * 1024); } while (0)
#define PG8_LDB(dst, b, h) do { _Pragma("unroll") for (int n = 0; n < 2; ++n) _Pragma("unroll") for (int k = 0; k < 2; ++k) dst[n][k] = *(const PG8_LAS bf16x8*)(lds + PG8_SB(b, h) + boff + n * 2048 + k * 1024); } while (0)
#define PG8_MMA(ai, bj, At, Bt) do { __builtin_amdgcn_s_setprio(1); _Pragma("unroll") for (int m = 0; m < 4; ++m) _Pragma("unroll") for (int n = 0; n < 2; ++n) _Pragma("unroll") for (int k = 0; k < 2; ++k) \
        acc[ai][bj][m][n] = __builtin_amdgcn_mfma_f32_16x16x32_bf16(Bt[n][k], At[m][k], acc[ai][bj][m][n], 0, 0, 0); __builtin_amdgcn_s_setprio(0); } while (0)
#define PG8_WAIT_V(n) asm volatile("s_waitcnt vmcnt(" #n ")" ::: "memory")
#define PG8_WAIT_L(n) asm volatile("s_waitcnt lgkmcnt(" #n ")" ::: "memory")
#define PG8_BAR __builtin_amdgcn_s_barrier()
#define PG8_SCHED __builtin_amdgcn_sched_barrier(0)
    Unit cur, nxt; int ui = 0;
    if (!S.next(0, cur)) return;
    f32x4 acc[2][2][4][2];
#pragma unroll
    for (int a = 0; a < 2; ++a)
#pragma unroll
        for (int b = 0; b < 2; ++b)
#pragma unroll
            for (int m = 0; m < 4; ++m)
#pragma unroll
                for (int n = 0; n < 2; ++n) acc[a][b][m][n] = (f32x4){0.f, 0.f, 0.f, 0.f};
    bf16x8 At[4][2], B0[2][2], B1[2][2];
    const char* cA = (const char*)g.A + (size_t)cur.pm * tstep; const char* cB = (const char*)g.Bt + (size_t)cur.pn * tstep;
    S.a_ready(cur);
    if constexpr (SP2) {
        PG8_STAGE(PG8_SB(0, 0), cB, voffB); PG8_STAGE(PG8_SB(0, 1), cB + hstep, voffB); PG8_STAGE(PG8_SA(0, 0), cA, voffA); PG8_STAGE(PG8_SA(0, 1), cA + hstep, voffA);
        if (wr == 1) PG8_BAR;
        PG8_WAIT_V(2); PG8_BAR;
        PG8_STAGE(PG8_SB(1, 0), cB + kstep, voffB); PG8_STAGE(PG8_SA(1, 0), cA + kstep, voffA); PG8_STAGE(PG8_SB(1, 1), cB + hstep + kstep, voffB);
        PG8_WAIT_V(6); PG8_BAR;
    } else {
        PG8_STAGE(PG8_SB(0, 0), cB, voffB); PG8_STAGE(PG8_SA(0, 0), cA, voffA); PG8_STAGE(PG8_SB(0, 1), cB + hstep, voffB); PG8_STAGE(PG8_SA(0, 1), cA + hstep, voffA);
        if (wr == 1) PG8_BAR;
        PG8_WAIT_V(4); PG8_BAR;
        PG8_STAGE(PG8_SB(1, 0), cB + kstep, voffB); PG8_STAGE(PG8_SA(1, 0), cA + kstep, voffA); PG8_STAGE(PG8_SB(1, 1), cB + hstep + kstep, voffB);
        PG8_WAIT_V(6); PG8_BAR;
    }
    for (;;) {
        const bool has_next = S.next(ui + 1, nxt);
        const char* nA = has_next ? (const char*)g.A + (size_t)nxt.pm * tstep : cA; const char* nB = has_next ? (const char*)g.Bt + (size_t)nxt.pn * tstep : cB;
        for (int t = 0; t < nt; t += 2) {
            const bool last = (t == nt - 2);
            const char* a1 = cA + (size_t)(t + 1) * kstep;
            const char* a2 = last ? nA : cA + (size_t)(t + 2) * kstep; const char* b2 = last ? nB : cB + (size_t)(t + 2) * kstep;
            const char* a3 = a2 + kstep; const char* b3 = b2 + kstep;
            if (last && has_next) S.a_ready(nxt);
            if constexpr (SP2) {
            PG8_LDB(B0, 0, 0); PG8_LDB(B1, 0, 1); PG8_SCHED; PG8_LDA(At, 0, 0); PG8_STAGE(PG8_SA(1, 1), a1 + hstep, voffA);
            PG8_WAIT_V(8); PG8_WAIT_L(0); PG8_BAR; PG8_MMA(0, 0, At, B0); PG8_MMA(0, 1, At, B1); PG8_BAR; PG8_SCHED;
            PG8_LDA(At, 0, 1); PG8_STAGE(PG8_SB(0, 0), b2, voffB); PG8_STAGE(PG8_SB(0, 1), b2 + hstep, voffB); PG8_STAGE(PG8_SA(0, 0), a2, voffA);
            PG8_WAIT_V(8); PG8_WAIT_L(0); PG8_BAR; PG8_MMA(1, 0, At, B0); PG8_MMA(1, 1, At, B1); PG8_BAR; PG8_SCHED;
            PG8_LDB(B0, 1, 0); PG8_LDB(B1, 1, 1); PG8_SCHED; PG8_LDA(At, 1, 0); PG8_STAGE(PG8_SA(0, 1), a2 + hstep, voffA);
            PG8_WAIT_V(8); PG8_WAIT_L(0); PG8_BAR; PG8_MMA(0, 0, At, B0); PG8_MMA(0, 1, At, B1); PG8_BAR; PG8_SCHED;
            PG8_LDA(At, 1, 1); PG8_STAGE(PG8_SB(1, 0), b3, voffB); PG8_STAGE(PG8_SB(1, 1), b3 + hstep, voffB); PG8_STAGE(PG8_SA(1, 0), a3, voffA);
            PG8_WAIT_V(8); PG8_WAIT_L(0); PG8_BAR; PG8_MMA(1, 0, At, B0); PG8_MMA(1, 1, At, B1); PG8_BAR; PG8_SCHED;
            } else {
            PG8_LDB(B0, 0, 0); PG8_SCHED; PG8_LDA(At, 0, 0); PG8_STAGE(PG8_SA(1, 1), a1 + hstep, voffA);
            PG8_WAIT_L(8); PG8_BAR; PG8_WAIT_L(0); PG8_MMA(0, 0, At, B0); PG8_BAR; PG8_SCHED;
            PG8_LDB(B1, 0, 1); PG8_STAGE(PG8_SB(0, 0), b2, voffB);
            PG8_BAR; PG8_WAIT_L(0); PG8_MMA(0, 1, At, B1); PG8_BAR;
            PG8_LDA(At, 0, 1); PG8_STAGE(PG8_SA(0, 0), a2, voffA);
            PG8_BAR; PG8_WAIT_L(0); PG8_MMA(1, 0, At, B0); PG8_BAR; PG8_SCHED;
            PG8_STAGE(PG8_SB(0, 1), b2 + hstep, voffB);
            PG8_WAIT_V(6); PG8_BAR; PG8_MMA(1, 1, At, B1); PG8_BAR;
            PG8_LDB(B0, 1, 0); PG8_SCHED; PG8_LDA(At, 1, 0); PG8_STAGE(PG8_SA(0, 1), a2 + hstep, voffA);
            PG8_WAIT_L(8); PG8_BAR; PG8_WAIT_L(0); PG8_MMA(0, 0, At, B0); PG8_BAR; PG8_SCHED;
            PG8_LDB(B1, 1, 1); PG8_STAGE(PG8_SB(1, 0), b3, voffB);
            PG8_BAR; PG8_WAIT_L(0); PG8_MMA(0, 1, At, B1); PG8_BAR;
            PG8_LDA(At, 1, 1); PG8_STAGE(PG8_SA(1, 0), a3, voffA);
            PG8_BAR; PG8_WAIT_L(0); PG8_MMA(1, 0, At, B0); PG8_BAR; PG8_SCHED;
            PG8_STAGE(PG8_SB(1, 1), b3 + hstep, voffB);
            PG8_WAIT_V(6); PG8_BAR; PG8_MMA(1, 1, At, B1); PG8_BAR;
            }
        }
        if constexpr (ALIGN_EPI) { if (wr == 0) PG8_BAR; }
        if constexpr (!Epi::AFTER_DRAIN) { E(acc, cur, wr, wc, fr, fq); S.done(cur); }
        if (!has_next) break;
#pragma unroll
        for (int a = 0; a < 2; ++a)
#pragma unroll
            for (int b = 0; b < 2; ++b)
#pragma unroll
                for (int m = 0; m < 4; ++m)
#pragma unroll
                    for (int n = 0; n < 2; ++n) acc[a][b][m][n] = (f32x4){0.f, 0.f, 0.f, 0.f};
        cur = nxt; cA = nA; cB = nB; ++ui;
        if constexpr (ALIGN_EPI) { if (wr == 1) PG8_BAR; }
    }
    PG8_WAIT_V(0);
    if constexpr (!ALIGN_EPI) { if (wr == 0) PG8_BAR; }
    PG8_BAR;
    if constexpr (Epi::AFTER_DRAIN) { E.fused(acc, cur, wr, wc, fr, fq, lds, wid, lane); S.done(cur); }
#undef PG8_SA
#undef PG8_SB
#undef PG8_STAGE
#undef PG8_LDA
#undef PG8_LDB
#undef PG8_MMA
#undef PG8_WAIT_V
#undef PG8_WAIT_L
#undef PG8_BAR
#undef PG8_SCHED
}
}
typedef unsigned short bf16_t;
typedef short bf16x8 __attribute__((ext_vector_type(8)));
typedef short s16x4 __attribute__((ext_vector_type(4)));
typedef float f32x4 __attribute__((ext_vector_type(4)));
typedef float f32x16 __attribute__((ext_vector_type(16)));
typedef unsigned u32x4 __attribute__((ext_vector_type(4)));
typedef unsigned u32x2 __attribute__((ext_vector_type(2)));
#define LAS __attribute__((address_space(3)))
constexpr int NTOK = 32768, DM = 1024, DFF = 2816, PW = 2560, SEQ = 4096, NBATCH = 8, NLAYER = 2;
constexpr int AQ = 0, AK = 512, AV = 1024, BQ = 1536, BK = 1792, BV = 1920, CQ = 2048, CK = 2304, CV = 2432;
constexpr float EPS = 1e-6f;
constexpr float QSCALE = 0.125f * 1.4426950408889634f;
constexpr int NWAVES = 8, NTHREADS = 512;
constexpr int LDS_BYTES = 147456;
constexpr size_t MiB = 1u << 20;
constexpr size_t WS_COS1 = 1 * MiB, WS_SIN1 = WS_COS1 + 512 * 1024, WS_COSX = 2 * MiB, WS_SINX = WS_COSX + 4096;
constexpr size_t WS_W = 4 * MiB, W_LAYER = 40 * MiB;
constexpr size_t WO_GU1 = 0, WO_D1 = 11 * MiB, WO_IN = WO_D1 + 5 * MiB + 512 * 1024, WO_OUT = WO_IN + 5 * MiB, WO_GU2 = WO_OUT + 2 * MiB, WO_D2 = WO_GU2 + 11 * MiB;
static_assert(WO_D2 + 5 * MiB + 512 * 1024 == W_LAYER, "weights per layer");
constexpr size_t WS_H = 84 * MiB, WS_U = 148 * MiB, WS_PROJ = WS_U, WS_ATTA = 324 * MiB, WS_ATTB = 420 * MiB, WS_ATTC = 436 * MiB, WS_LA = 452 * MiB, WS_END = 468 * MiB;
constexpr size_t WS_SS = 456 * MiB;
constexpr size_t WS_RS = 3 * MiB;
constexpr size_t WS_CAT = WS_PROJ;

__device__ __forceinline__ unsigned f2bf(float f) { unsigned u = __builtin_bit_cast(unsigned, f); return (u + 0x7fffu + ((u >> 16) & 1u)) >> 16; }
__device__ __forceinline__ unsigned pk2(float lo, float hi) { return f2bf(lo) | (f2bf(hi) << 16); }
__device__ __forceinline__ float bf2f(unsigned short b) { return __builtin_bit_cast(float, (unsigned)b << 16); }
__device__ __forceinline__ float bflo(unsigned w) { return __builtin_bit_cast(float, w << 16); }
__device__ __forceinline__ float bfhi(unsigned w) { return __builtin_bit_cast(float, w & 0xffff0000u); }
__device__ __forceinline__ float wave_sum(float v) {
#pragma unroll
    for (int o = 1; o < 64; o <<= 1) v += __shfl_xor(v, o);
    return v;
}
__device__ __forceinline__ float wave_max(float v) {
#pragma unroll
    for (int o = 1; o < 64; o <<= 1) v = fmaxf(v, __shfl_xor(v, o));
    return v;
}

__device__ __forceinline__ int fresh_tid(int wave0) { return wave0 * 64 + lane_id_fresh(); }
__device__ __forceinline__ int pax(int e) { return 8 * ((e & 15) >> 2) + 4 * (e >> 4) + (e & 3); }
__device__ __forceinline__ void transpose_item(const float* W, int K, int N, bf16_t* WT, int rbase, bool axial, const float* gk, LAS float* scr, int kb, int nb, int lane, float wsc = 1.0f) {
    const int k0 = 64 * kb, n0 = 32 * nb;
#pragma unroll 8
    for (int i = 0; i < 32; ++i) { const int kk = 2 * i + (lane >> 5); scr[kk * 33 + (lane & 31)] = W[(size_t)(k0 + kk) * N + n0 + (lane & 31)]; }
    asm volatile("s_waitcnt lgkmcnt(0)" ::: "memory");
    const int c = lane & 7;
    f32x4 g0 = {1.f, 1.f, 1.f, 1.f}, g1 = g0;
    if (gk) { g0 = *(const f32x4*)(gk + k0 + 8 * c) * wsc; g1 = *(const f32x4*)(gk + k0 + 8 * c + 4) * wsc; }
#pragma unroll
    for (int j = 0; j < 4; ++j) { const int n = (lane >> 3) + 8 * j; const LAS float* s = scr + (8 * c) * 33 + n;
        u32x4 o; o.x = pk2(s[0 * 33] * g0.x, s[1 * 33] * g0.y); o.y = pk2(s[2 * 33] * g0.z, s[3 * 33] * g0.w); o.z = pk2(s[4 * 33] * g1.x, s[5 * 33] * g1.y); o.w = pk2(s[6 * 33] * g1.z, s[7 * 33] * g1.w);
        const int r = rbase + (axial ? pax(n) : n);
        *(u32x4*)(WT + (size_t)r * K + k0 + 8 * c) = o; }
    asm volatile("s_waitcnt lgkmcnt(0)" ::: "memory");
}
__device__ __forceinline__ void transpose_matrix(const float* W, int K, int N, bf16_t* WT, int mode, const float* gk, LAS float* scr, int gw, int NGW, int lane) {
    const int nblk = N / 32, nitems = (K / 64) * nblk;
    for (int it = gw; it < nitems; it += NGW) {
        const int kb = it / nblk, nb = it % nblk; const int n0 = nb * 32;
        int rbase = n0; bool axial = false;
        if (mode == 1 || mode == 2) rbase = n0 + (n0 >> 7) * 128 + (mode == 2 ? 128 : 0);
        else if (mode == 3) { const int h = n0 >> 6, half = (n0 >> 5) & 1; rbase = 256 * (h >> 2) + 128 * half + 32 * (h & 3); axial = (h >= 24 && h < 30); }
        transpose_item(W, K, N, WT, rbase, axial, gk, scr, kb, nb, lane, mode == 1 ? -1.4426950408889634f : 1.0f);
    }
}
__device__ __forceinline__ void x_prep(const float* x, bf16_t* XB, float* ss, int gw, int NGW, int lane) {
    for (int m = gw; m < NTOK; m += NGW) {
        const f32x4* xr = (const f32x4*)(x + (size_t)m * DM) + lane; f32x4 v[4]; float s = 0.f;
#pragma unroll
        for (int j = 0; j < 4; ++j) { v[j] = xr[64 * j]; s += (v[j].x * v[j].x + v[j].y * v[j].y) + (v[j].z * v[j].z + v[j].w * v[j].w); }
        s = wave_sum(s);
        u32x2* o = (u32x2*)(XB + (size_t)m * DM) + lane;
#pragma unroll
        for (int j = 0; j < 4; ++j) { u32x2 w; w.x = pk2(v[j].x, v[j].y); w.y = pk2(v[j].z, v[j].w); o[64 * j] = w; }
        if (lane == 0) ss[m] = 1.0f / sqrtf(s * (1.0f / DM) + EPS);
    }
}
__device__ __forceinline__ void sincos_rev(float ang, float& c, float& s) {
    double r = (double)ang * 0.15915494309189533577; r -= __builtin_rint(r);
    const float rf = (float)r; s = __builtin_amdgcn_sinf(rf); c = __builtin_amdgcn_cosf(rf);
}
__device__ __forceinline__ void rope_tables(float* cos1, float* sin1, float* cosx, float* sinx, int gtid, int NGT) {
    for (int i = gtid; i < SEQ * 32; i += NGT) { const int t = i >> 5, j = i & 31;
        const float inv = 1.0f / __builtin_powf(10000.0f, (float)(2 * j) / 64.0f); const float ang = (float)t * inv; float c, s; sincos_rev(ang, c, s); cos1[i] = c; sin1[i] = s; }
    for (int i = gtid; i < 64 * 16; i += NGT) { const int p = i >> 4, j = i & 15;
        const float inv = 1.0f / __builtin_powf(10000.0f, (float)(2 * j) / 32.0f); const float ang = (float)p * inv; float c, s; sincos_rev(ang, c, s); cosx[i] = c; sinx[i] = s; }
}

__device__ __forceinline__ unsigned cvtpk(float lo, float hi) { typedef float f2 __attribute__((ext_vector_type(2))); typedef __bf16 b2 __attribute__((ext_vector_type(2)));
    f2 v = {lo, hi}; b2 b = __builtin_convertvector(v, b2); return __builtin_bit_cast(unsigned, b); }
typedef short v4i16_t __attribute__((ext_vector_type(4)));
__device__ __forceinline__ s16x4 vtr(LAS const unsigned char* p) { return __builtin_bit_cast(s16x4, __builtin_amdgcn_ds_read_tr16_b64_v4i16((LAS v4i16_t*)p)); }
__device__ __forceinline__ int crow(int r, int hi) { return (r & 3) + 8 * (r >> 2) + 4 * hi; }

#define SBAR() __builtin_amdgcn_sched_barrier(0)
__device__ __forceinline__ void k_load(LAS const unsigned char* kb, int r32, int hi, bf16x8 (&kf)[8]) {
#pragma unroll
    for (int d0 = 0; d0 < 4; ++d0) { const int c = 2 * d0 + hi;
        kf[2 * d0] = *(LAS const bf16x8*)(kb + c * 1024 + ((r32 ^ c) * 16));
        kf[2 * d0 + 1] = *(LAS const bf16x8*)(kb + c * 1024 + 512 + ((r32 ^ c) * 16)); }
}
__device__ __forceinline__ void qk_mma(const bf16x8 (&kf)[8], const bf16x8 (&qf)[4], f32x16& s0, f32x16& s1) {
    const f32x16 z = {0.f, 0.f, 0.f, 0.f, 0.f, 0.f, 0.f, 0.f, 0.f, 0.f, 0.f, 0.f, 0.f, 0.f, 0.f, 0.f};
    s0 = __builtin_amdgcn_mfma_f32_32x32x16_bf16(kf[0], qf[0], z, 0, 0, 0); s1 = __builtin_amdgcn_mfma_f32_32x32x16_bf16(kf[1], qf[0], z, 0, 0, 0);
#pragma unroll
    for (int d0 = 1; d0 < 4; ++d0) { s0 = __builtin_amdgcn_mfma_f32_32x32x16_bf16(kf[2 * d0], qf[d0], s0, 0, 0, 0); s1 = __builtin_amdgcn_mfma_f32_32x32x16_bf16(kf[2 * d0 + 1], qf[d0], s1, 0, 0, 0); }
}
__device__ __forceinline__ void v_load(LAS const unsigned char* vb, s16x4 (&vf)[16]) {
#pragma unroll
    for (int s = 0; s < 4; ++s)
#pragma unroll
        for (int d0 = 0; d0 < 2; ++d0) { vf[4 * s + 2 * d0] = vtr(vb + d0 * 4096 + s * 1024); vf[4 * s + 2 * d0 + 1] = vtr(vb + d0 * 4096 + s * 1024 + 512); }
}
__device__ __forceinline__ void pv_mma(const s16x4 (&vf)[16], const u32x4 (&pw)[4], f32x16 (&o)[2]) {
#pragma unroll
    for (int s = 0; s < 4; ++s)
#pragma unroll
        for (int d0 = 0; d0 < 2; ++d0) { const s16x4 lo = vf[4 * s + 2 * d0], hh = vf[4 * s + 2 * d0 + 1];
            const bf16x8 v = (bf16x8){lo[0], lo[1], lo[2], lo[3], hh[0], hh[1], hh[2], hh[3]};
            o[d0] = __builtin_amdgcn_mfma_f32_32x32x16_bf16(v, __builtin_bit_cast(bf16x8, pw[s]), o[d0], 0, 0, 0); }
}
template <bool BAND, bool SHIFT>
__device__ __forceinline__ void softmax_tile(f32x16& s0, f32x16& s1, bool full, int base, int radius, float negshift, float& lsum, u32x4 (&pw)[4]) {
    if (SHIFT) {
#pragma unroll
        for (int r = 0; r < 16; ++r) { s0[r] += negshift; s1[r] += negshift; } }
#pragma unroll
    for (int r = 0; r < 16; ++r) { s0[r] = __builtin_amdgcn_exp2f(s0[r]); s1[r] = __builtin_amdgcn_exp2f(s1[r]); }
    if (BAND) { if (!full) {
#pragma unroll
        for (int r = 0; r < 16; ++r) { const int d = base + (r & 3) + 8 * (r >> 2); const int d1 = d + 32;
            if (d > radius || d < -radius) s0[r] = 0.f;
            if (d1 > radius || d1 < -radius) s1[r] = 0.f; } } }
    {   float t[8];
#pragma unroll
        for (int i = 0; i < 8; ++i) t[i] = (s0[i] + s0[i + 8]) + (s1[i] + s1[i + 8]);
        lsum += ((t[0] + t[1]) + (t[2] + t[3])) + ((t[4] + t[5]) + (t[6] + t[7])); }
#pragma unroll
    for (int s = 0; s < 2; ++s) {
        pw[s] = (u32x4){cvtpk(s0[8 * s + 0], s0[8 * s + 1]), cvtpk(s0[8 * s + 2], s0[8 * s + 3]), cvtpk(s0[8 * s + 4], s0[8 * s + 5]), cvtpk(s0[8 * s + 6], s0[8 * s + 7])};
        pw[2 + s] = (u32x4){cvtpk(s1[8 * s + 0], s1[8 * s + 1]), cvtpk(s1[8 * s + 2], s1[8 * s + 3]), cvtpk(s1[8 * s + 4], s1[8 * s + 5]), cvtpk(s1[8 * s + 6], s1[8 * s + 7])};
    }
}
template <bool BAND, bool SHIFT>
__device__ __forceinline__ void attn_core(LAS unsigned char* lds, const bf16_t* Kp, const bf16_t* Vp, size_t kvstride, const bf16_t* Qp, size_t qstride,
                                          int qslot0, int t_lo, int t_hi, int radius, float negshift, f32x16 (&o)[2], float& lsum, const int wave0) {
    const int tid = fresh_tid(wave0), lane = tid & 63, r32 = lane & 31, hi = lane >> 5;
    const int srow = tid >> 3, sch = tid & 7;
    bf16x8 qf[4];
#pragma unroll
    for (int d0 = 0; d0 < 4; ++d0) qf[d0] = *(const bf16x8*)(Qp + (size_t)r32 * qstride + d0 * 16 + hi * 8);
#pragma unroll
    for (int r = 0; r < 16; ++r) { o[0][r] = 0.f; o[1][r] = 0.f; }
    lsum = 0.f;
    const unsigned kw = (unsigned)(sch * 1024 + ((srow ^ sch) * 16));
    const unsigned vw = (unsigned)(16384 + (sch >> 2) * 4096 + (srow >> 4) * 1024 + (srow & 15) * 64 + (sch & 3) * 16);
    const unsigned voff = (unsigned)(((lane >> 4) & 1) * 32 + (lane & 3) * 8 + (4 * hi + ((lane & 15) >> 2)) * 64);
    const bf16_t* kg = Kp + (size_t)srow * kvstride + sch * 8;
    const bf16_t* vg = Vp + (size_t)srow * kvstride + sch * 8;
    const int tlast = t_hi - 1;
    const int n_it = (t_hi - t_lo + 1) >> 1;
    u32x4 kr0, vr0, kr1, vr1;
    { const size_t o0 = (size_t)(t_lo * 64) * kvstride; const int tb = (t_lo + 1 < t_hi) ? t_lo + 1 : tlast; const size_t o1 = (size_t)(tb * 64) * kvstride;
      kr0 = *(const u32x4*)(kg + o0); vr0 = *(const u32x4*)(vg + o0); kr1 = *(const u32x4*)(kg + o1); vr1 = *(const u32x4*)(vg + o1); }
    *(LAS u32x4*)(lds + kw) = kr0; *(LAS u32x4*)(lds + 8192 + kw) = kr1; *(LAS u32x4*)(lds + vw) = vr0; *(LAS u32x4*)(lds + 8192 + vw) = vr1;
    __syncthreads();
    for (int it = 0; it < n_it; ++it) {
        const unsigned bo = (unsigned)((it & 1) * 32768);
        const bool more = (it + 1 < n_it);
        const int tA = t_lo + 2 * it, tB = tA + 1;
        if (more) { const int ta = tA + 2; const int tb = (ta + 1 < t_hi) ? ta + 1 : tlast; const size_t o0 = (size_t)(ta * 64) * kvstride, o1 = (size_t)(tb * 64) * kvstride;
            kr0 = *(const u32x4*)(kg + o0); vr0 = *(const u32x4*)(vg + o0); kr1 = *(const u32x4*)(kg + o1); vr1 = *(const u32x4*)(vg + o1); }
        bool actA = true, actB = (tB < t_hi), fullA = true, fullB = true;
        const int kvA = tA * 64, kvB = tB * 64;
        if (BAND) {
            actA = !(kvA > qslot0 + 31 + radius || kvA + 63 < qslot0 - radius);
            actB = actB && !(kvB > qslot0 + 31 + radius || kvB + 63 < qslot0 - radius);
            fullA = (kvA >= qslot0 + 31 - radius) && (kvA + 63 <= qslot0 + radius);
            fullB = (kvB >= qslot0 + 31 - radius) && (kvB + 63 <= qslot0 + radius);
        }
        LAS const unsigned char* kbA = lds + bo; LAS const unsigned char* kbB = lds + bo + 8192;
        LAS const unsigned char* vbA = lds + bo + 16384 + voff; LAS const unsigned char* vbB = lds + bo + 24576 + voff;
        const int baseA = kvA + 4 * hi - (qslot0 + r32), baseB = baseA + 64;
        if (!BAND) {
            f32x16 a0, a1, b0, b1; u32x4 pa[4], pb[4]; s16x4 vfa[16], vfb[16]; bf16x8 kfa[8], kfb[8];
            k_load(kbA, r32, hi, kfa); SBAR();
            qk_mma(kfa, qf, a0, a1); v_load(vbA, vfa); k_load(kbB, r32, hi, kfb); SBAR();
            qk_mma(kfb, qf, b0, b1);
            softmax_tile<BAND, SHIFT>(a0, a1, true, 0, 0, negshift, lsum, pa);
#pragma unroll
            for (int i = 0; i < 8; ++i) { __builtin_amdgcn_sched_group_barrier(0x008, 1, 0); __builtin_amdgcn_sched_group_barrier(0x402, 9, 0); }
            SBAR();
            if (more) { const unsigned nb = bo ^ 32768u; *(LAS u32x4*)(lds + nb + kw) = kr0; *(LAS u32x4*)(lds + nb + 8192 + kw) = kr1; *(LAS u32x4*)(lds + nb + vw) = vr0; *(LAS u32x4*)(lds + nb + 8192 + vw) = vr1; }
            v_load(vbB, vfb); SBAR();
            pv_mma(vfa, pa, o);
            softmax_tile<BAND, SHIFT>(b0, b1, true, 0, 0, negshift, lsum, pb);
#pragma unroll
            for (int i = 0; i < 8; ++i) { __builtin_amdgcn_sched_group_barrier(0x008, 1, 0); __builtin_amdgcn_sched_group_barrier(0x402, 9, 0); }
            SBAR();
            pv_mma(vfb, pb, o); SBAR();
        } else {
#pragma unroll 1
            for (int h = 0; h < 2; ++h) {
                const bool act = h ? actB : actA;
                if (act) {
                    f32x16 a0, a1; u32x4 pa[4]; s16x4 vf[16]; bf16x8 kf[8];
                    LAS const unsigned char* kb1 = h ? kbB : kbA; LAS const unsigned char* vb1 = h ? vbB : vbA;
                    k_load(kb1, r32, hi, kf); SBAR(); qk_mma(kf, qf, a0, a1); SBAR();
                    v_load(vb1, vf); SBAR();
                    softmax_tile<BAND, SHIFT>(a0, a1, h ? fullB : fullA, h ? baseB : baseA, radius, negshift, lsum, pa);
                    SBAR(); pv_mma(vf, pa, o); SBAR();
                }
            }
        }
        if (BAND && more) { const unsigned nb = bo ^ 32768u; *(LAS u32x4*)(lds + nb + kw) = kr0; *(LAS u32x4*)(lds + nb + 8192 + kw) = kr1; *(LAS u32x4*)(lds + nb + vw) = vr0; *(LAS u32x4*)(lds + nb + 8192 + vw) = vr1; }
        __syncthreads();
    }
}
__device__ __forceinline__ void store_o(LAS unsigned char* stg, bf16_t* orow0, size_t ostride, const f32x16 (&o)[2], float sc, int lane) {
    const int r32 = lane & 31, hi = lane >> 5;
#pragma unroll
    for (int d0 = 0; d0 < 2; ++d0)
#pragma unroll
        for (int g = 0; g < 4; ++g) { u32x2 w; w.x = cvtpk(o[d0][4 * g] * sc, o[d0][4 * g + 1] * sc); w.y = cvtpk(o[d0][4 * g + 2] * sc, o[d0][4 * g + 3] * sc);
            const int ch = 4 * d0 + g; *(LAS u32x2*)(stg + r32 * 128 + ((ch ^ (r32 & 7)) * 16) + hi * 8) = w; }
#pragma unroll
    for (int p = 0; p < 4; ++p) { const int row = 8 * p + (lane >> 3), ci = lane & 7;
        const u32x4 v = *(LAS const u32x4*)(stg + row * 128 + ((ci ^ (row & 7)) * 16));
        *(u32x4*)(orow0 + (size_t)row * ostride + ci * 8) = v; }
}
struct BandUnit { const bf16_t* Kp; const bf16_t* Vp; const bf16_t* Qp; size_t stride; bf16_t* orow0; float* lrow0; int ostride, lstride; int qslot0, t_lo, t_hi, radius; float negshift, lextra, isC; };
__device__ __forceinline__ void band_issue(const BandUnit& u, int srow, int sch, u32x4 (&st)[12], bf16x8 (&qf)[4], int r32, int hi) {
#pragma unroll
    for (int j = 0; j < 6; ++j) { int t = u.t_lo + j; if (t > u.t_hi - 1) t = u.t_hi - 1;
        const size_t off = (size_t)(t * 64 + srow) * u.stride + sch * 8;
        st[2 * j] = *(const u32x4*)(u.Kp + off); st[2 * j + 1] = *(const u32x4*)(u.Vp + off); }
#pragma unroll
    for (int d0 = 0; d0 < 4; ++d0) qf[d0] = *(const bf16x8*)(u.Qp + (size_t)r32 * u.stride + d0 * 16 + hi * 8);
}
__device__ __forceinline__ void band_compute(LAS unsigned char* lds, const BandUnit& u, const bf16x8 (&qf)[4], int r32, int hi, unsigned voff, f32x16 (&o)[2], float& lsum) {
#pragma unroll
    for (int r = 0; r < 16; ++r) { o[0][r] = 0.f; o[1][r] = 0.f; }
    lsum = 0.f;
#pragma unroll 1
    for (int jh = 0; jh < 12; ++jh) {
        const int t = u.t_lo + (jh >> 1), hh = jh & 1; const int kv0 = t * 64 + 32 * hh;
        const bool act = (t < u.t_hi) && !(kv0 > u.qslot0 + 31 + u.radius || kv0 + 31 < u.qslot0 - u.radius);
        if (act) {
            const bool full = (kv0 >= u.qslot0 + 31 - u.radius) && (kv0 + 31 <= u.qslot0 + u.radius);
            const int base = kv0 + 4 * hi - (u.qslot0 + r32);
            LAS const unsigned char* kb = lds + (jh >> 1) * 16384 + hh * 512; LAS const unsigned char* vb = lds + (jh >> 1) * 16384 + 8192 + voff + hh * 2048;
            bf16x8 kf[4]; s16x4 vf[8]; f32x16 sa;
#pragma unroll
            for (int d0 = 0; d0 < 4; ++d0) { const int c = 2 * d0 + hi; kf[d0] = *(LAS const bf16x8*)(kb + c * 1024 + ((r32 ^ c) * 16)); }
            SBAR();
            { const f32x16 z = {0.f, 0.f, 0.f, 0.f, 0.f, 0.f, 0.f, 0.f, 0.f, 0.f, 0.f, 0.f, 0.f, 0.f, 0.f, 0.f};
              sa = __builtin_amdgcn_mfma_f32_32x32x16_bf16(kf[0], qf[0], z, 0, 0, 0);
#pragma unroll
              for (int d0 = 1; d0 < 4; ++d0) sa = __builtin_amdgcn_mfma_f32_32x32x16_bf16(kf[d0], qf[d0], sa, 0, 0, 0); }
            SBAR();
#pragma unroll
            for (int s = 0; s < 2; ++s)
#pragma unroll
                for (int d0 = 0; d0 < 2; ++d0) { vf[4 * s + 2 * d0] = vtr(vb + d0 * 4096 + s * 1024); vf[4 * s + 2 * d0 + 1] = vtr(vb + d0 * 4096 + s * 1024 + 512); }
            SBAR();
            if (u.negshift != 0.f) {
#pragma unroll
                for (int r = 0; r < 16; ++r) sa[r] += u.negshift; }
#pragma unroll
            for (int r = 0; r < 16; ++r) sa[r] = __builtin_amdgcn_exp2f(sa[r]);
            if (!full) {
                if (kv0 + 31 > u.qslot0 + u.radius) { const int thr = u.radius - base;
#pragma unroll
                    for (int r = 0; r < 16; ++r) { if ((r & 3) + 8 * (r >> 2) > thr) sa[r] = 0.f; } }
                else { const int thr = -u.radius - base;
#pragma unroll
                    for (int r = 0; r < 16; ++r) { if ((r & 3) + 8 * (r >> 2) < thr) sa[r] = 0.f; } } }
            lsum += (((sa[0] + sa[8]) + (sa[1] + sa[9])) + ((sa[2] + sa[10]) + (sa[3] + sa[11]))) + (((sa[4] + sa[12]) + (sa[5] + sa[13])) + ((sa[6] + sa[14]) + (sa[7] + sa[15])));
            u32x4 pw[2];
#pragma unroll
            for (int s = 0; s < 2; ++s) pw[s] = (u32x4){cvtpk(sa[8 * s + 0], sa[8 * s + 1]), cvtpk(sa[8 * s + 2], sa[8 * s + 3]), cvtpk(sa[8 * s + 4], sa[8 * s + 5]), cvtpk(sa[8 * s + 6], sa[8 * s + 7])};
            SBAR();
#pragma unroll
            for (int s = 0; s < 2; ++s)
#pragma unroll
                for (int d0 = 0; d0 < 2; ++d0) { const s16x4 lo = vf[4 * s + 2 * d0], hh2 = vf[4 * s + 2 * d0 + 1];
                    const bf16x8 v = (bf16x8){lo[0], lo[1], lo[2], lo[3], hh2[0], hh2[1], hh2[2], hh2[3]};
                    o[d0] = __builtin_amdgcn_mfma_f32_32x32x16_bf16(v, __builtin_bit_cast(bf16x8, pw[s]), o[d0], 0, 0, 0); }
            SBAR();
        }
    }
}
struct AttnArgs { const bf16_t* P; bf16_t* OA; bf16_t* OB; bf16_t* OC; float* LA; const float *aqn, *akn, *bqn, *bkn, *cqn, *ckn, *sink; };
__device__ __forceinline__ BandUnit band_decode(const AttnArgs& A, int idx, int wave, float shA, float shC0) {
    const float L2E = 1.4426950408889634f;
    BandUnit u;
    if (idx < 1024) {
        const int j0 = idx & 511; const int cc = j0 & 255, pass = j0 >> 8;
        const int pair = (cc & 7) + 8 * pass; const int batch = pair >> 1, g = pair & 1, qb = cc >> 3;
        const int r = wave >> 2, sub = wave & 3, qh = 2 * g + r;
        u.qslot0 = qb * 128 + sub * 32;
        const bf16_t* base = A.P + (size_t)batch * SEQ * PW;
        u.Qp = base + (size_t)u.qslot0 * PW + CQ + qh * 64; u.Kp = base + CK + g * 64; u.Vp = base + CV + g * 64; u.stride = PW;
        const float sk = A.sink[qh] * L2E; const float sh = (sk > 64.f || shC0 != 0.f) ? fmaxf(shC0, sk) : 0.f;
        u.negshift = -sh; u.lextra = __builtin_amdgcn_exp2f(sk - sh); u.isC = 1.f; u.radius = 128;
        int t_lo = 2 * qb - 2, t_hi = 2 * qb + 4; if (t_lo < 0) t_lo = 0; if (t_hi > 64) t_hi = 64; u.t_lo = t_lo; u.t_hi = t_hi;
        u.orow0 = A.OC + ((size_t)batch * SEQ + u.qslot0) * 256 + qh * 64; u.lrow0 = nullptr; u.ostride = 256; u.lstride = 0;
    } else {
        const int j = idx - 1024; const int cc = j & 255, pass = j >> 8, jx = cc >> 3;
        const int st = (cc & 7) + 8 * (2 * pass + (jx >> 4));
        const int br = st >> 6, batch = (st >> 3) & 7, head = st & 7, blk = jx & 15;
        const int dil = br == 0 ? 1 : (br == 1 ? 4 : 16); const int nbr = 16 / dil;
        const int res = blk / nbr, sb = blk % nbr; const int slot0 = sb * 256; const int L = SEQ / dil;
        u.qslot0 = slot0 + 32 * wave;
        const bf16_t* base = A.P + ((size_t)batch * SEQ + res) * PW;
        u.stride = (size_t)dil * PW;
        u.Qp = base + (size_t)u.qslot0 * u.stride + AQ + head * 64; u.Kp = base + AK + head * 64; u.Vp = base + AV + head * 64;
        int t_lo = slot0 / 64 - 1, t_hi = slot0 / 64 + 5; if (t_lo < 0) t_lo = 0; if (t_hi > L / 64) t_hi = L / 64; u.t_lo = t_lo; u.t_hi = t_hi;
        u.negshift = -shA; u.lextra = 0.f; u.isC = 0.f; u.radius = 64;
        const size_t tok = (size_t)batch * SEQ + (size_t)u.qslot0 * dil + res;
        u.orow0 = A.OA + ((size_t)br * NTOK + tok) * 512 + head * 64; u.lrow0 = A.LA + ((size_t)br * NTOK + tok) * 8 + head; u.ostride = dil * 512; u.lstride = dil * 8;
    }
    return u;
}
__device__ __forceinline__ void attn_phase(LAS unsigned char* lds, const AttnArgs& A, int wg, int NWG, int wave, int lane) {
    const int r32 = lane & 31, hi = lane >> 5;
    const float L2E = 1.4426950408889634f;
    float shA = 8.0f * wave_max(fabsf(A.aqn[lane])) * wave_max(fabsf(A.akn[lane])) * L2E; if (shA < 64.f) shA = 0.f;
    float shB = 8.0f * wave_max(fabsf(A.bqn[lane])) * wave_max(fabsf(A.bkn[lane])) * L2E; if (shB < 64.f) shB = 0.f;
    float shC0 = 8.0f * wave_max(fabsf(A.cqn[lane])) * wave_max(fabsf(A.ckn[lane])) * L2E; if (shC0 < 64.f) shC0 = 0.f;
    shA = __builtin_bit_cast(float, __builtin_amdgcn_readfirstlane(__builtin_bit_cast(int, shA)));
    shB = __builtin_bit_cast(float, __builtin_amdgcn_readfirstlane(__builtin_bit_cast(int, shB)));
    shC0 = __builtin_bit_cast(float, __builtin_amdgcn_readfirstlane(__builtin_bit_cast(int, shC0)));
    for (int idx = wg; idx < 512; idx += NWG) {
        f32x16 o[2]; float lsum;
        const int cc = idx & 255, pass = idx >> 8;
        const int pair = (cc & 7) + 8 * pass; const int batch = pair >> 1, g = pair & 1, qb = cc >> 3;
        const int r = wave >> 2, sub = wave & 3, qh = 2 * g + r;
        const int qslot0 = qb * 128 + sub * 32;
        const bf16_t* base = A.P + (size_t)batch * SEQ * PW;
        const bf16_t* Qp = base + (size_t)qslot0 * PW + BQ + qh * 64;
        const bf16_t* Kp = base + BK + g * 64;
        const bf16_t* Vp = base + BV + g * 64;
        if (shB != 0.f) attn_core<false, true>(lds, Kp, Vp, PW, Qp, PW, qslot0, 0, 64, 0, -shB, o, lsum, wave);
        else attn_core<false, false>(lds, Kp, Vp, PW, Qp, PW, qslot0, 0, 64, 0, 0.f, o, lsum, wave);
        const float l = lsum + __shfl_xor(lsum, 32);
        bf16_t* orow0 = A.OB + ((size_t)batch * SEQ + qslot0) * 256 + qh * 64;
        store_o(lds + 98304 + wave * 4096, orow0, 256, o, 1.0f / l, lane);
    }
    {
        const int lane = lane_id_fresh(), r32 = lane & 31, hi = lane >> 5;
        const int tid = wave * 64 + lane; const int srow = tid >> 3, sch = tid & 7;
        const unsigned kw = (unsigned)(sch * 1024 + ((srow ^ sch) * 16));
        const unsigned vw0 = (unsigned)(8192 + (sch >> 2) * 4096 + (srow >> 4) * 1024 + (srow & 15) * 64 + (sch & 3) * 16);
        const unsigned voff = (unsigned)(((lane >> 4) & 1) * 32 + (lane & 3) * 8 + (4 * hi + ((lane & 15) >> 2)) * 64);
        u32x4 st[12]; bf16x8 qn[4];
        int idx = 512 + wg;
        if (idx < 4096) { const BandUnit nu = band_decode(A, idx, wave, shA, shC0); band_issue(nu, srow, sch, st, qn, r32, hi); }
        for (; idx < 4096; idx += NWG) {
            const BandUnit u = band_decode(A, idx, wave, shA, shC0);
            bf16x8 qf[4];
#pragma unroll
            for (int d0 = 0; d0 < 4; ++d0) qf[d0] = qn[d0];
#pragma unroll
            for (int j = 0; j < 6; ++j) { *(LAS u32x4*)(lds + j * 16384 + kw) = st[2 * j]; *(LAS u32x4*)(lds + j * 16384 + vw0) = st[2 * j + 1]; }
            __syncthreads();
            if (idx + NWG < 4096) { const BandUnit nu = band_decode(A, idx + NWG, wave, shA, shC0); band_issue(nu, srow, sch, st, qn, r32, hi); }
            f32x16 o[2]; float lsum;
            band_compute(lds, u, qf, r32, hi, voff, o, lsum);
            const float l = lsum + __shfl_xor(lsum, 32) + u.lextra;
            store_o(lds + 98304 + wave * 4096, u.orow0, (size_t)u.ostride, o, (u.isC != 0.f) ? 1.0f / l : 1.0f, lane);
            if (u.isC == 0.f && hi == 0) u.lrow0[(size_t)r32 * u.lstride] = l;
            __syncthreads();
        }
    }
}
__device__ __forceinline__ void combine_phase(const bf16_t* OA, const float* LA, const bf16_t* OB, const bf16_t* OC, const float* gg, bf16_t* CAT, int gw, int NGW, int lane) {
    const f32x4 ga0 = ((const f32x4*)gg)[lane * 2], ga1 = ((const f32x4*)gg)[lane * 2 + 1];
    const f32x4 gb = ((const f32x4*)(gg + 512))[lane], gc = ((const f32x4*)(gg + 768))[lane];
    const int head = lane >> 3;
    for (int m0 = gw * 2; m0 < NTOK; m0 += NGW * 2) {
        u32x4 wa[2][3]; float la[2][3]; u32x2 wb[2], wc[2];
#pragma unroll
        for (int u = 0; u < 2; ++u) { const int m = m0 + u;
#pragma unroll
            for (int br = 0; br < 3; ++br) { la[u][br] = LA[((size_t)br * NTOK + m) * 8 + head]; wa[u][br] = *(const u32x4*)(OA + ((size_t)br * NTOK + m) * 512 + lane * 8); }
            wb[u] = *(const u32x2*)(OB + (size_t)m * 256 + lane * 4); wc[u] = *(const u32x2*)(OC + (size_t)m * 256 + lane * 4); }
#pragma unroll
        for (int u = 0; u < 2; ++u) { const int m = m0 + u;
            float v[8];
#pragma unroll
            for (int i = 0; i < 8; ++i) v[i] = 0.f;
#pragma unroll
            for (int br = 0; br < 3; ++br) { const u32x4 w = wa[u][br];
                v[0] += bflo(w.x); v[1] += bfhi(w.x); v[2] += bflo(w.y); v[3] += bfhi(w.y); v[4] += bflo(w.z); v[5] += bfhi(w.z); v[6] += bflo(w.w); v[7] += bfhi(w.w); }
            const float il = 1.0f / ((la[u][0] + la[u][1]) + la[u][2]); float ss = 0.f;
#pragma unroll
            for (int i = 0; i < 8; ++i) { v[i] *= il; ss += v[i] * v[i]; }
            const float b0 = bflo(wb[u].x), b1 = bfhi(wb[u].x), b2 = bflo(wb[u].y), b3 = bfhi(wb[u].y);
            const float c0 = bflo(wc[u].x), c1 = bfhi(wc[u].x), c2 = bflo(wc[u].y), c3 = bfhi(wc[u].y);
            float sb = (b0 * b0 + b1 * b1) + (b2 * b2 + b3 * b3), sc = (c0 * c0 + c1 * c1) + (c2 * c2 + c3 * c3);
#pragma unroll
            for (int o = 1; o < 64; o <<= 1) { ss += __shfl_xor(ss, o); sb += __shfl_xor(sb, o); sc += __shfl_xor(sc, o); }
            const float ra = 1.0f / sqrtf(ss * (1.0f / 512.0f) + EPS), rb = 1.0f / sqrtf(sb * (1.0f / 256.0f) + EPS), rc = 1.0f / sqrtf(sc * (1.0f / 256.0f) + EPS);
            u32x4 wo; wo.x = pk2(v[0] * ra * ga0.x, v[1] * ra * ga0.y); wo.y = pk2(v[2] * ra * ga0.z, v[3] * ra * ga0.w);
            wo.z = pk2(v[4] * ra * ga1.x, v[5] * ra * ga1.y); wo.w = pk2(v[6] * ra * ga1.z, v[7] * ra * ga1.w);
            *(u32x4*)(CAT + (size_t)m * DM + lane * 8) = wo;
            u32x2 q; q.x = pk2(b0 * rb * gb.x, b1 * rb * gb.y); q.y = pk2(b2 * rb * gb.z, b3 * rb * gb.w);
            *(u32x2*)(CAT + (size_t)m * DM + 512 + lane * 4) = q;
            u32x2 r; r.x = pk2(c0 * rc * gc.x, c1 * rc * gc.y); r.y = pk2(c2 * rc * gc.z, c3 * rc * gc.w);
            *(u32x2*)(CAT + (size_t)m * DM + 768 + lane * 4) = r;
        }
    }
}

#define GAS __attribute__((address_space(1)))
#define XB_TMO      128
#define XB_XCNT(j)  (256  + 64 * (j))
#define XB_XSUB(j)  (1280 + 64 * (j))
#define XB_XGEN(j)  (2304 + 64 * (j))
#define XB_TOP      3328
#define XB_TOPGEN   3392
#define XCD_BAR_WORDS 3456
#define XB_SPIN_CAP (1u << 18)

__device__ __forceinline__ unsigned xb_ld(unsigned* p)              { return __hip_atomic_load(p, __ATOMIC_RELAXED, __HIP_MEMORY_SCOPE_AGENT); }
__device__ __forceinline__ unsigned xb_add(unsigned* p, unsigned v) { return __hip_atomic_fetch_add(p, v, __ATOMIC_RELAXED, __HIP_MEMORY_SCOPE_AGENT); }
__device__ __forceinline__ unsigned xb_xcc_id() { return (unsigned)__builtin_amdgcn_s_getreg((3 << 11) | 20) & 0xFu; }
#define XB_SPIN(cond, bar) do { unsigned _sp = 0; while (cond) { __builtin_amdgcn_s_sleep(1); \
    if ((++_sp & 255u) == 0u) { if (xb_ld(&(bar)[XB_TMO])) break; if (_sp > XB_SPIN_CAP) { atomicAdd(&(bar)[XB_TMO], 1u); break; } } } } while (0)

struct XcdBarrier {
    unsigned* bar; unsigned x;
    volatile LAS unsigned* st;
};

__device__ __forceinline__ XcdBarrier xcd_barrier_post(unsigned* bar, volatile LAS unsigned* st, const int tid0) {
    XcdBarrier b; b.bar = bar; b.x = xb_xcc_id(); b.st = st;
    if (tid0 == 0) (void)xb_add(&bar[XB_XCNT(b.x)], 1u);
    return b;
}
__device__ __forceinline__ void xcd_barrier_complete(unsigned* bar, unsigned x, unsigned& nloc, unsigned& nx) {
    const unsigned G = gridDim.x * gridDim.y * gridDim.z;
    unsigned sum, cnt, mine, sp = 0u;
    for (;;) {
        sum = 0u; cnt = 0u; mine = 0u;
#pragma unroll
        for (unsigned j = 0; j < 16; ++j) { const unsigned c = xb_ld(&bar[XB_XCNT(j)]); sum += c; cnt += (c > 0u) ? 1u : 0u; mine = (j == x) ? c : mine; }
        if (sum == G) break;
        __builtin_amdgcn_s_sleep(1);
        if ((++sp & 255u) == 0u) { if (xb_ld(&bar[XB_TMO])) break; if (sp > XB_SPIN_CAP) { atomicAdd(&bar[XB_TMO], 1u); break; } }
    }
    nloc = mine > 0u ? mine : 1u; nx = cnt > 0u ? cnt : 1u;
}

__device__ __forceinline__ void xcd_barrier(const XcdBarrier& b, const int tid0) {
    asm volatile("s_waitcnt vmcnt(0)" ::: "memory");
    __syncthreads();
    if (tid0 == 0) {
        unsigned* bar = b.bar;
        __builtin_amdgcn_s_waitcnt(0);
        unsigned nloc = b.st[0], nx = b.st[1];
        if (nloc == 0u) { xcd_barrier_complete(bar, b.x, nloc, nx); b.st[0] = nloc; b.st[1] = nx; }
        const unsigned old = xb_add(&bar[XB_XSUB(b.x)], 1u);
        const unsigned gen = old / nloc;
        if (old + 1u == (gen + 1u) * nloc) {
            __builtin_amdgcn_fence(__ATOMIC_RELEASE, "agent");
            asm volatile("s_waitcnt vmcnt(0)" ::: "memory");
            const unsigned og = xb_add(&bar[XB_TOP], 1u);
            const unsigned tg = og / nx;
            if (og + 1u == (tg + 1u) * nx) xb_add(&bar[XB_TOPGEN], 1u);
            else XB_SPIN(xb_ld(&bar[XB_TOPGEN]) == tg, bar);
            __builtin_amdgcn_fence(__ATOMIC_ACQUIRE, "agent");
            xb_add(&bar[XB_XGEN(b.x)], 1u);
            asm volatile("s_waitcnt vmcnt(0)" ::: "memory");
        } else {
            XB_SPIN(xb_ld(&bar[XB_XGEN(b.x)]) == gen, bar);
            __builtin_amdgcn_fence(__ATOMIC_ACQUIRE, "agent");
            asm volatile("s_waitcnt vmcnt(0)" ::: "memory");
        }
    }
    __syncthreads();
}

__device__ __forceinline__ void finalize_rs(const float* ssp, float* rs, int gtid, int NGT) {
    for (int i = gtid; i < NTOK; i += NGT) { const f32x4* p = (const f32x4*)(ssp + (size_t)i * 16);
        const f32x4 a = p[0], b = p[1], c = p[2], d = p[3];
        const float s = (((a[0] + a[1]) + (a[2] + a[3])) + ((b[0] + b[1]) + (b[2] + b[3]))) + (((c[0] + c[1]) + (c[2] + c[3])) + ((d[0] + d[1]) + (d[2] + d[3])));
        rs[i] = 1.0f / sqrtf(s * (1.0f / DM) + EPS); }
}
struct Args { const float* in[20]; float* out; unsigned char* ws; };
typedef const volatile Args __attribute__((address_space(4))) * kargp_t;
#define KARG() ((kargp_t)__builtin_amdgcn_kernarg_segment_ptr())
#define LD_IN(i) ((const float*)KARG()->in[i])
#define LD_WS() ((unsigned char*)KARG()->ws)
#define LD_OUT() ((float*)KARG()->out)
__global__ void __launch_bounds__(NTHREADS, 2) fwd_megakernel(Args a_unused) {
    extern __shared__ __attribute__((aligned(16))) unsigned char lds_raw[];
    LAS unsigned char* lds = (LAS unsigned char*)lds_raw;
    cg::grid_group grid = cg::this_grid();
    const int G = gridDim.x, wg = blockIdx.x;
    const int NGW = G * NWAVES;
    const int wave0 = __builtin_amdgcn_readfirstlane(threadIdx.x >> 6);
#define FRESH() const int wave = fresh_wave(wave0), tid = fresh_tid(wave), lane = tid & 63, gw = wg * NWAVES + wave; (void)lane; (void)gw
    volatile LAS unsigned* bst = (volatile LAS unsigned*)(lds + 131072 + 512);
    {   unsigned* barw = (unsigned*)(LD_WS() + 0);
        if (threadIdx.x < 2) bst[threadIdx.x] = 0u;
        if (wg == 0) for (int i = threadIdx.x; i < XCD_BAR_WORDS; i += NTHREADS) barw[i] = 0u;
        __syncthreads(); }
    {
        FRESH();
        unsigned char* ws = LD_WS();
        LAS float* scr = (LAS float*)(lds + wave * 16384);
        for (int l = 0; l < NLAYER; ++l) {
            unsigned char* wl = ws + WS_W + (size_t)l * W_LAYER;
            const float* g1 = LD_IN(1) + (size_t)l * DM; const float* gm = LD_IN(5) + (size_t)l * DM; const float* g2 = LD_IN(16) + (size_t)l * DM;
            transpose_matrix(LD_IN(2) + (size_t)l * DM * DFF, DM, DFF, (bf16_t*)(wl + WO_GU1), 1, g1, scr, gw, NGW, lane);
            transpose_matrix(LD_IN(3) + (size_t)l * DM * DFF, DM, DFF, (bf16_t*)(wl + WO_GU1), 2, g1, scr, gw, NGW, lane);
            transpose_matrix(LD_IN(4) + (size_t)l * DFF * DM, DFF, DM, (bf16_t*)(wl + WO_D1), 0, nullptr, scr, gw, NGW, lane);
            transpose_matrix(LD_IN(6) + (size_t)l * DM * PW, DM, PW, (bf16_t*)(wl + WO_IN), 3, gm, scr, gw, NGW, lane);
            transpose_matrix(LD_IN(15) + (size_t)l * DM * DM, DM, DM, (bf16_t*)(wl + WO_OUT), 0, nullptr, scr, gw, NGW, lane);
            transpose_matrix(LD_IN(17) + (size_t)l * DM * DFF, DM, DFF, (bf16_t*)(wl + WO_GU2), 1, g2, scr, gw, NGW, lane);
            transpose_matrix(LD_IN(18) + (size_t)l * DM * DFF, DM, DFF, (bf16_t*)(wl + WO_GU2), 2, g2, scr, gw, NGW, lane);
            transpose_matrix(LD_IN(19) + (size_t)l * DFF * DM, DFF, DM, (bf16_t*)(wl + WO_D2), 0, nullptr, scr, gw, NGW, lane);
        }
        rope_tables((float*)(ws + WS_COS1), (float*)(ws + WS_SIN1), (float*)(ws + WS_COSX), (float*)(ws + WS_SINX), wg * NTHREADS + tid, G * NTHREADS);
        x_prep(LD_IN(0), (bf16_t*)(ws + WS_H), (float*)(ws + WS_RS), gw, NGW, lane);
    }
    grid.sync();
    const XcdBarrier xbar = xcd_barrier_post((unsigned*)(LD_WS() + 0), bst, fresh_tid(wave0));
#define GSYNC() xcd_barrier(xbar, fresh_tid(wave0))
#define GEMM_PHASE(EPI, Aoff, Woff, N_, K_, ...) do { unsigned char* ws = LD_WS(); unsigned char* wl = ws + WS_W + (size_t)l * W_LAYER; \
        pg8::Gemm g{(const bf16_t*)(ws + (Aoff)), (const bf16_t*)(wl + (Woff)), NTOK, (N_), (K_)}; pg8::StaticOrder S; S.init(NTOK, (N_), G, fresh_wave(wg)); \
        pg8::EPI E{__VA_ARGS__}; pg8::gemm_phase<pg8::EPI, pg8::StaticOrder, true, true>(lds, g, S, E, wave0); } while (0)
#define FINALIZE() do { FRESH(); unsigned char* ws = LD_WS(); finalize_rs((const float*)(ws + WS_SS), (float*)(ws + WS_RS), wg * NTHREADS + tid, G * NTHREADS); } while (0)

#pragma nounroll
    for (int l = 0; l < NLAYER; ++l) {
        const bool lastl = (l + 1 == NLAYER);
        GEMM_PHASE(EpiSwiglu, WS_H, WO_GU1, 2 * DFF, DM, (bf16_t*)(ws + WS_U), DFF, (const float*)(ws + WS_RS));
        GSYNC();
        GEMM_PHASE(EpiResid, WS_U, WO_D1, DM, DFF, (bf16_t*)(ws + WS_H), (float*)nullptr, DM, 0.5f, (float*)(ws + WS_SS), (const float*)(ws + WS_RS), -0.6931471805599453f);
        GSYNC(); FINALIZE(); GSYNC();
        GEMM_PHASE(EpiQKV, WS_H, WO_IN, PW, DM, (bf16_t*)(ws + WS_PROJ), (const float*)(ws + WS_RS), LD_IN(7) + l * 64, LD_IN(8) + l * 64, LD_IN(9) + l * 64, LD_IN(10) + l * 64, LD_IN(11) + l * 64, LD_IN(12) + l * 64,
                   (const float*)(ws + WS_COS1), (const float*)(ws + WS_SIN1), (const float*)(ws + WS_COSX), (const float*)(ws + WS_SINX), QSCALE);
        GSYNC();
        { FRESH(); unsigned char* ws = LD_WS();
          AttnArgs A{(const bf16_t*)(ws + WS_PROJ), (bf16_t*)(ws + WS_ATTA), (bf16_t*)(ws + WS_ATTB), (bf16_t*)(ws + WS_ATTC), (float*)(ws + WS_LA),
                     LD_IN(7) + l * 64, LD_IN(8) + l * 64, LD_IN(9) + l * 64, LD_IN(10) + l * 64, LD_IN(11) + l * 64, LD_IN(12) + l * 64, LD_IN(13) + l * 4};
          attn_phase(lds, A, fresh_wave(wg), G, wave, lane); }
        GSYNC();
        { FRESH(); unsigned char* ws = LD_WS();
          combine_phase((const bf16_t*)(ws + WS_ATTA), (const float*)(ws + WS_LA), (const bf16_t*)(ws + WS_ATTB), (const bf16_t*)(ws + WS_ATTC), LD_IN(14) + (size_t)l * DM, (bf16_t*)(ws + WS_CAT), gw, NGW, lane); }
        GSYNC();
        GEMM_PHASE(EpiResid, WS_CAT, WO_OUT, DM, DM, (bf16_t*)(ws + WS_H), (float*)nullptr, DM, 1.0f, (float*)(ws + WS_SS), (const float*)nullptr, 1.0f);
        GSYNC(); FINALIZE(); GSYNC();
        GEMM_PHASE(EpiSwiglu, WS_H, WO_GU2, 2 * DFF, DM, (bf16_t*)(ws + WS_U), DFF, (const float*)(ws + WS_RS));
        GSYNC();
        GEMM_PHASE(EpiResid, WS_U, WO_D2, DM, DFF, (bf16_t*)(ws + WS_H), lastl ? LD_OUT() : (float*)nullptr, DM, 0.5f, (float*)(ws + WS_SS), (const float*)(ws + WS_RS), -0.6931471805599453f);
        if (!lastl) { GSYNC(); FINALIZE(); GSYNC(); }
    }
}

extern "C" void kernel_launch(void* const* d_in, const int* in_sizes, int n_in, void* d_out, int out_size, void* d_ws, size_t ws_size, hipStream_t stream) {
    static int grid = 0;
    if (grid == 0) {
        if (n_in != 20 || out_size != NTOK * DM || ws_size < WS_END) { fprintf(stderr, "kernel_launch: unexpected shapes (n_in %d out %d ws %zu)\n", n_in, out_size, ws_size); grid = -1; return; }
        int dev = 0, cus = 0, per_cu = 0;
        hipGetDevice(&dev); hipDeviceGetAttribute(&cus, hipDeviceAttributeMultiprocessorCount, dev);
        hipFuncSetAttribute((const void*)fwd_megakernel, hipFuncAttributeMaxDynamicSharedMemorySize, LDS_BYTES);
        hipOccupancyMaxActiveBlocksPerMultiprocessor(&per_cu, (const void*)fwd_megakernel, NTHREADS, LDS_BYTES);
        if (per_cu < 1) { fprintf(stderr, "kernel_launch: occupancy query says %d blocks/CU\n", per_cu); per_cu = 1; }
        (void)hipGetLastError();
        grid = cus;
    }
    if (grid < 0) return;
    Args a{};
    for (int i = 0; i < 20; ++i) a.in[i] = (const float*)d_in[i];
    a.out = (float*)d_out; a.ws = (unsigned char*)d_ws;
    void* args[] = {&a};
    hipError_t e = hipLaunchCooperativeKernel((const void*)fwd_megakernel, dim3(grid), dim3(NTHREADS), args, LDS_BYTES, stream);
    if (e != hipSuccess) fprintf(stderr, "cooperative launch failed: %s (grid %d)\n", hipGetErrorString(e), grid);
}
```
